# Optimizing an MI355X kernel written in HIP

```python
import jax, jax.numpy as jnp
from jax import lax
import numpy as np

D_MODEL = 1024
BATCH = 8
SEQ = 2048
DEPTH = 2
DEC_BATCH = 128
DEC_SEQ = 1
PAST_LEN = 16384
PAGE_SIZE = 128

HEAD_DIM = 64
D_MIX = D_MODEL
D_A = 3 * D_MIX // 8
D_C = 3 * D_MIX // 8
D_B = D_MIX - D_A - D_C
POOL_WINDOWS = (2, 4, 8, 16)
N_POOL_GROUPS = len(POOL_WINDOWS)
POOL_GROUP_DIM = D_B // N_POOL_GROUPS
POOL_STATE = max(POOL_WINDOWS) - 1
CONV_A_WIDTH = 31
CONV_C_WIDTH = 3
D_IN = 2 * D_A + D_B + 3 * D_C
D_FF = 4 * D_MODEL
D_PLE = 256
EPS = 1e-6

kernel_name = "hybrid_conv_pool_shortconv_decoder_step"


def rms_norm(x, g):
    x32 = x.astype(jnp.float32)
    y = x32 * lax.rsqrt(jnp.mean(x32 * x32, axis=-1, keepdims=True) + EPS)
    return (y * g.astype(jnp.float32)).astype(x.dtype)


def layer_norm(x, g, b):
    x32 = x.astype(jnp.float32)
    mu = jnp.mean(x32, axis=-1, keepdims=True)
    xc = x32 - mu
    var = jnp.mean(xc * xc, axis=-1, keepdims=True)
    y = xc * lax.rsqrt(var + EPS)
    return (y * g.astype(jnp.float32) + b.astype(jnp.float32)).astype(x.dtype)


def causal_depthwise_conv(xe, w):
    c = xe.shape[-1]
    rhs = w.astype(xe.dtype)[:, None, :]
    return lax.conv_general_dilated(xe, rhs, window_strides=(1,), padding="VALID",
                                    dimension_numbers=("NWC", "WIO", "NWC"),
                                    feature_group_count=c)


def multiscale_pool(ue, pos0):
    t_new = ue.shape[1] - POOL_STATE
    u32 = ue.astype(jnp.float32)
    cs = jnp.pad(jnp.cumsum(u32, axis=1), ((0, 0), (1, 0), (0, 0)))
    end = cs[:, POOL_STATE + 1:]
    pos = pos0 + jnp.arange(t_new, dtype=jnp.int32)
    parts = []
    for g, w in enumerate(POOL_WINDOWS):
        sl = slice(g * POOL_GROUP_DIM, (g + 1) * POOL_GROUP_DIM)
        start = cs[:, POOL_STATE + 1 - w: POOL_STATE + 1 - w + t_new, sl]
        count = jnp.minimum(pos + 1, w).astype(jnp.float32)[None, :, None]
        parts.append((end[..., sl] - start) / count)
    pooled = jnp.concatenate(parts, axis=-1)
    return (pooled - u32[:, POOL_STATE:]).astype(ue.dtype)


def trunk_layer(h, p_i, st_a, st_p, st_c, pos0,
                g_mix, w_in, conv_a_w, conv_a_b, ln_a_g, ln_a_b, pool_w, pool_scale,
                conv_c_w, w_out, g_mlp, w_up, w_down, g_ple, w_ple_gate, w_ple_proj):
    bsz, t_new, _ = h.shape
    n = rms_norm(h, g_mix)
    z = n @ w_in
    a_v, a_g, u_b, c_b, c_c, c_x = jnp.split(
        z, np.cumsum([D_A, D_A, D_B, D_C, D_C]).tolist(), axis=-1)

    glu = a_v * jax.nn.sigmoid(a_g)
    ge = jnp.concatenate([st_a, glu], axis=1)
    ya = causal_depthwise_conv(ge, conv_a_w) + conv_a_b
    out_a = jax.nn.silu(layer_norm(ya, ln_a_g, ln_a_b))
    new_a = ge[:, -(CONV_A_WIDTH - 1):]

    ue = jnp.concatenate([st_p, u_b], axis=1)
    pooled = multiscale_pool(ue, pos0).reshape(bsz, t_new, N_POOL_GROUPS, POOL_GROUP_DIM)
    out_b = jnp.einsum("btgc,gcd->btgd", pooled, pool_w).reshape(bsz, t_new, D_B) * pool_scale
    new_p = ue[:, -POOL_STATE:]

    ve = jnp.concatenate([st_c, c_c * c_x], axis=1)
    out_c = c_b * causal_depthwise_conv(ve, conv_c_w)
    new_c = ve[:, -(CONV_C_WIDTH - 1):]

    h = h + jnp.concatenate([out_a, out_b, out_c], axis=-1) @ w_out

    m = rms_norm(h, g_mlp)
    h = h + jnp.square(jax.nn.relu(m @ w_up)) @ w_down

    gate = jax.nn.sigmoid(rms_norm(h, g_ple) @ w_ple_gate)
    h = h + gate * (p_i @ w_ple_proj)
    return h, new_a, new_p, new_c


def setup_inputs(seed: int = 0) -> dict:
    key = jax.random.key(seed)
    ks = jax.random.split(key, 32)
    f32 = jnp.float32
    nrm = lambda k, shape, s: jax.random.normal(k, shape, f32) * s
    return {
        "x_prompt": nrm(ks[0], (BATCH, SEQ, D_MODEL), 1.0),
        "x_sample": nrm(ks[1], (DEC_BATCH, DEC_SEQ, D_MODEL), 1.0),
        "state_conv_a": nrm(ks[2], (DEPTH, DEC_BATCH, CONV_A_WIDTH - 1, D_A), 1.0),
        "state_pool": nrm(ks[3], (DEPTH, DEC_BATCH, POOL_STATE, D_B), 1.0),
        "state_conv_c": nrm(ks[4], (DEPTH, DEC_BATCH, CONV_C_WIDTH - 1, D_C), 1.0),
        "p_prompt": nrm(ks[5], (DEPTH, BATCH, SEQ, D_PLE), 1.0),
        "p_sample": nrm(ks[6], (DEPTH, DEC_BATCH, DEC_SEQ, D_PLE), 1.0),
        "norm_mix_g": 1.0 + nrm(ks[7], (DEPTH, D_MODEL), 0.05),
        "w_in": nrm(ks[8], (DEPTH, D_MODEL, D_IN), D_MODEL ** -0.5),
        "conv_a_w": nrm(ks[9], (DEPTH, CONV_A_WIDTH, D_A), CONV_A_WIDTH ** -0.5),
        "conv_a_b": nrm(ks[10], (DEPTH, D_A), 0.02),
        "ln_a_g": 1.0 + nrm(ks[11], (DEPTH, D_A), 0.05),
        "ln_a_b": nrm(ks[12], (DEPTH, D_A), 0.02),
        "pool_w": nrm(ks[13], (DEPTH, N_POOL_GROUPS, POOL_GROUP_DIM, POOL_GROUP_DIM), POOL_GROUP_DIM ** -0.5),
        "pool_scale": 1.0 + nrm(ks[14], (DEPTH, D_B), 0.1),
        "conv_c_w": nrm(ks[15], (DEPTH, CONV_C_WIDTH, D_C), CONV_C_WIDTH ** -0.5),
        "w_out": nrm(ks[16], (DEPTH, D_MIX, D_MODEL), D_MIX ** -0.5),
        "norm_mlp_g": 1.0 + nrm(ks[17], (DEPTH, D_MODEL), 0.05),
        "w_up": nrm(ks[18], (DEPTH, D_MODEL, D_FF), D_MODEL ** -0.5),
        "w_down": nrm(ks[19], (DEPTH, D_FF, D_MODEL), D_FF ** -0.5),
        "norm_ple_g": 1.0 + nrm(ks[20], (DEPTH, D_MODEL), 0.05),
        "w_ple_gate": nrm(ks[21], (DEPTH, D_MODEL, D_MODEL), D_MODEL ** -0.5),
        "w_ple_proj": nrm(ks[22], (DEPTH, D_PLE, D_MODEL), D_PLE ** -0.5),
        "final_norm_g": 1.0 + nrm(ks[23], (D_MODEL,), 0.05),
    }


def reference(x_prompt, x_sample, state_conv_a, state_pool, state_conv_c, p_prompt, p_sample,
              norm_mix_g, w_in, conv_a_w, conv_a_b, ln_a_g, ln_a_b, pool_w, pool_scale, conv_c_w,
              w_out, norm_mlp_g, w_up, w_down, norm_ple_g, w_ple_gate, w_ple_proj, final_norm_g):
    bp = x_prompt.shape[0]
    dt = x_prompt.dtype
    zero_a = jnp.zeros((bp, CONV_A_WIDTH - 1, D_A), dt)
    zero_p = jnp.zeros((bp, POOL_STATE, D_B), dt)
    zero_c = jnp.zeros((bp, CONV_C_WIDTH - 1, D_C), dt)
    hp, hs = x_prompt, x_sample
    pa, pp, pc, sa, sp, sc = [], [], [], [], [], []
    for i in range(DEPTH):
        lw = (norm_mix_g[i], w_in[i], conv_a_w[i], conv_a_b[i], ln_a_g[i], ln_a_b[i], pool_w[i],
              pool_scale[i], conv_c_w[i], w_out[i], norm_mlp_g[i], w_up[i], w_down[i],
              norm_ple_g[i], w_ple_gate[i], w_ple_proj[i])
        hp, a_i, p_i, c_i = trunk_layer(hp, p_prompt[i], zero_a, zero_p, zero_c, 0, *lw)
        hs, a_j, p_j, c_j = trunk_layer(hs, p_sample[i], state_conv_a[i], state_pool[i],
                                        state_conv_c[i], PAST_LEN, *lw)
        pa.append(a_i); pp.append(p_i); pc.append(c_i)
        sa.append(a_j); sp.append(p_j); sc.append(c_j)
    y_prompt = rms_norm(hp, final_norm_g)
    y_sample = rms_norm(hs, final_norm_g)
    new_conv_a_prompt = jnp.stack(pa)
    new_pool_prompt = jnp.stack(pp)
    new_conv_c_prompt = jnp.stack(pc)
    new_conv_a_sample = jnp.stack(sa)
    new_pool_sample = jnp.stack(sp)
    new_conv_c_sample = jnp.stack(sc)
    return (y_prompt, y_sample, new_conv_a_prompt, new_pool_prompt, new_conv_c_prompt,
            new_conv_a_sample, new_pool_sample, new_conv_c_sample)
```

```cpp
#include <hip/hip_runtime.h>
#include <hip/hip_cooperative_groups.h>
#include <cstdio>
#include <cstdint>
namespace cg = cooperative_groups;
namespace pg8 {
#define PG8_LAS __attribute__((address_space(3)))
#define PG8_TIDX(w0) ((int)((w0) << 6) + (int)__builtin_amdgcn_mbcnt_hi(~0u, __builtin_amdgcn_mbcnt_lo(~0u, 0u)))
typedef unsigned short bf16_t;
typedef short bf16x8 __attribute__((ext_vector_type(8)));
typedef float f32x4 __attribute__((ext_vector_type(4)));
typedef unsigned u32x4 __attribute__((ext_vector_type(4)));
constexpr int BM = 256, BK = 64, HALF = 128, HTB = HALF * BK * 2  , STAGE_BYTES = 8 * HTB, NXCD = 8, WGM = 8;

__host__ __device__ __forceinline__ int lds_byte(int r, int c) { const int st = (r >> 4) * 2 + (c >> 5), rr = r & 15, cc = c & 31, ob = rr * 64 + cc * 2; return st * 1024 + (ob ^ (((ob >> 9) & 1) << 5)); }
__host__ __device__ __forceinline__ void stage_rc(int b, int& R, int& C) { const int st = b / 1024, sb = b % 1024, swz = sb ^ (((sb >> 9) & 1) << 5); R = (st >> 1) * 16 + swz / 64; C = (st & 1) * 32 + (swz % 64) / 2; }
__host__ __device__ __forceinline__ int perm32(int rho) { const int n = rho >> 4, i = rho & 15; return 8 * (i >> 2) + 4 * n + (i & 3); }

struct Unit { int pm, pn; };
struct Gemm { const bf16_t* A; const bf16_t* Bt; int M, N, K; };

struct StaticOrder {
    int nM, nN, nwg, G, c;
    __host__ __device__ void init(int M, int N, int G_, int c_) { nM = M / BM; nN = N / BM; nwg = nM * nN; G = G_; c = c_; }
    __host__ __device__ bool next(int i, Unit& u) const {
        const long L = (long)i * G + c; if (L >= nwg) return false;
        int wgid = (int)L; { const int q = nwg / NXCD, r = nwg % NXCD, xcd = wgid % NXCD, off = wgid / NXCD; wgid = (xcd < r ? xcd * (q + 1) : r * (q + 1) + (xcd - r) * q) + off; }
        const int nig = WGM * nN, gid = wgid / nig, fm = gid * WGM, gsz = (nM - fm) < WGM ? (nM - fm) : WGM;
        u.pm = fm + ((wgid % nig) % gsz); u.pn = (wgid % nig) / gsz; return true;
    }
    __device__ __forceinline__ void a_ready(const Unit&) const {}
    __device__ __forceinline__ void done(const Unit&) const {}
};

__device__ __forceinline__ unsigned cvt_pk_bf16(float lo, float hi) { unsigned r; asm volatile("v_cvt_pk_bf16_f32 %0, %1, %2" : "=v"(r) : "v"(lo), "v"(hi)); return r; }

constexpr int ZLD = 4096;
__device__ __forceinline__ float sigm(float x) { return __builtin_amdgcn_rcpf(1.0f + __expf(-x)); }
__device__ __forceinline__ f32x4 sigm4_t(const f32x4 t) { f32x4 e; e[0] = __builtin_amdgcn_exp2f(t[0]); e[1] = __builtin_amdgcn_exp2f(t[1]); e[2] = __builtin_amdgcn_exp2f(t[2]); e[3] = __builtin_amdgcn_exp2f(t[3]); const f32x4 d = e + 1.0f; f32x4 r; r[0] = __builtin_amdgcn_rcpf(d[0]); r[1] = __builtin_amdgcn_rcpf(d[1]); r[2] = __builtin_amdgcn_rcpf(d[2]); r[3] = __builtin_amdgcn_rcpf(d[3]); return r; }
__device__ __forceinline__ float rs_of(float ssq) { return rsqrtf(ssq * (1.0f / 1024.0f) + 1e-6f); }
__device__ __forceinline__ float bf_lo(unsigned p) { return __uint_as_float(p << 16); }
__device__ __forceinline__ float bf_hi(unsigned p) { return __uint_as_float(p & 0xffff0000u); }
__device__ __forceinline__ void st8(bf16_t* p, const f32x4 a, const f32x4 b) { u32x4 w; w.x = cvt_pk_bf16(a[0], a[1]); w.y = cvt_pk_bf16(a[2], a[3]); w.z = cvt_pk_bf16(b[0], b[1]); w.w = cvt_pk_bf16(b[2], b[3]); *(u32x4*)p = w; }
__device__ __forceinline__ void ld8(const bf16_t* p, f32x4& a, f32x4& b) { const u32x4 w = *(const u32x4*)p; a = (f32x4){bf_lo(w.x), bf_hi(w.x), bf_lo(w.y), bf_hi(w.y)}; b = (f32x4){bf_lo(w.z), bf_hi(w.z), bf_lo(w.w), bf_hi(w.w)}; }
__device__ __forceinline__ float sq4(const f32x4 a) { return (a[0] * a[0] + a[1] * a[1]) + (a[2] * a[2] + a[3] * a[3]); }

struct EpiZ {
    static constexpr bool PERM = true, AFTER_DRAIN = false;
    bf16_t* Z; const float* ssq; int pn0;
    __device__ __forceinline__ void operator()(const f32x4 (&acc)[2][2][4][2], const Unit& u, int wr, int wc, int fr, int fq) const {
        const int row0 = u.pm * BM + wr * 64 + fr, pn = u.pn + pn0, cl = wc * 32 + 8 * fq;
#pragma unroll
        for (int ai = 0; ai < 2; ++ai)
#pragma unroll
            for (int m = 0; m < 4; ++m) {
                const int row = row0 + ai * HALF + m * 16; const float rs = rs_of(ssq[row]); bf16_t* zr = Z + (size_t)row * ZLD;
                if (pn < 6) {
                    const f32x4 a0 = acc[ai][0][m][0] * rs, a1 = acc[ai][0][m][1] * rs, b0 = acc[ai][1][m][0] * rs, b1 = acc[ai][1][m][1] * rs; f32x4 o0, o1;
                    if (pn < 3) {
                        o0 = a0 * sigm4_t(b0 * -1.4426950408889634f); o1 = a1 * sigm4_t(b1 * -1.4426950408889634f);
                    } else { o0 = a0 * b0; o1 = a1 * b1; }
                    st8(zr + (pn < 3 ? 128 * pn : 1024 + 128 * (pn - 3)) + cl, o0, o1);
                } else {
                    const int cb = pn == 6 ? 384 : (pn == 7 ? 640 : 896);
                    st8(zr + cb + cl, acc[ai][0][m][0] * rs, acc[ai][0][m][1] * rs);
                    if (pn != 8) st8(zr + cb + 128 + cl, acc[ai][1][m][0] * rs, acc[ai][1][m][1] * rs);
                }
            }
    }
};
struct EpiPlain {
    static constexpr bool PERM = true, AFTER_DRAIN = false;
    bf16_t* O; int ldc;
    __device__ __forceinline__ void operator()(const f32x4 (&acc)[2][2][4][2], const Unit& u, int wr, int wc, int fr, int fq) const {
        const int row0 = u.pm * BM + wr * 64 + fr, col0 = u.pn * BM + wc * 32 + 8 * fq;
#pragma unroll
        for (int ai = 0; ai < 2; ++ai)
#pragma unroll
            for (int m = 0; m < 4; ++m) { bf16_t* rp = O + (size_t)(row0 + ai * HALF + m * 16) * ldc + col0;
#pragma unroll
                for (int bj = 0; bj < 2; ++bj) st8(rp + bj * HALF, acc[ai][bj][m][0], acc[ai][bj][m][1]); }
    }
};
struct EpiRes {
    static constexpr bool PERM = true, AFTER_DRAIN = false;
    const bf16_t* hin; bf16_t* hout; float* ssqn;
    __device__ __forceinline__ void operator()(const f32x4 (&acc)[2][2][4][2], const Unit& u, int wr, int wc, int fr, int fq) const {
        const int row0 = u.pm * BM + wr * 64 + fr, col0 = u.pn * BM + wc * 32 + 8 * fq;
#pragma unroll
        for (int ai = 0; ai < 2; ++ai)
#pragma unroll
            for (int m = 0; m < 4; ++m) { const int row = row0 + ai * HALF + m * 16; const size_t off = (size_t)row * 1024 + col0; float sq = 0.f;
#pragma unroll
                for (int bj = 0; bj < 2; ++bj) { f32x4 h0, h1; ld8(hin + off + bj * HALF, h0, h1); h0 += acc[ai][bj][m][0]; h1 += acc[ai][bj][m][1]; sq += sq4(h0) + sq4(h1); st8(hout + off + bj * HALF, h0, h1); }
                sq += __shfl_xor(sq, 16); sq += __shfl_xor(sq, 32);
                if (fq == 0) unsafeAtomicAdd(ssqn + row, sq);
                asm volatile("" ::: "memory"); }
    }
};
struct EpiUp {
    static constexpr bool PERM = true, AFTER_DRAIN = false;
    bf16_t* U; const float* ssq;
    __device__ __forceinline__ void operator()(const f32x4 (&acc)[2][2][4][2], const Unit& u, int wr, int wc, int fr, int fq) const {
        const int row0 = u.pm * BM + wr * 64 + fr, col0 = u.pn * BM + wc * 32 + 8 * fq;
#pragma unroll
        for (int ai = 0; ai < 2; ++ai)
#pragma unroll
            for (int m = 0; m < 4; ++m) { const int row = row0 + ai * HALF + m * 16; const float rs = rs_of(ssq[row]); bf16_t* rp = U + (size_t)row * 4096 + col0;
#pragma unroll
                for (int bj = 0; bj < 2; ++bj) { f32x4 v0 = acc[ai][bj][m][0] * rs, v1 = acc[ai][bj][m][1] * rs;
#pragma unroll
                    for (int e = 0; e < 4; ++e) { v0[e] = fmaxf(v0[e], 0.f); v1[e] = fmaxf(v1[e], 0.f); }
                    st8(rp + bj * HALF, v0 * v0, v1 * v1); } }
    }
};
template <bool LAST> struct EpiGate {
    static constexpr bool PERM = true, AFTER_DRAIN = false;
    const bf16_t* hin; const bf16_t* P; bf16_t* hout; float* outf; const float* ssq; float* ssqn;
    __device__ __forceinline__ void operator()(const f32x4 (&acc)[2][2][4][2], const Unit& u, int wr, int wc, int fr, int fq) const {
        const int row0 = u.pm * BM + wr * 64 + fr, col0 = u.pn * BM + wc * 32 + 8 * fq;
#pragma unroll
        for (int ai = 0; ai < 2; ++ai)
#pragma unroll
            for (int m = 0; m < 4; ++m) { const int row = row0 + ai * HALF + m * 16; const float rs = rs_of(ssq[row]); const size_t off = (size_t)row * 1024 + col0; float sq = 0.f;
#pragma unroll
                for (int bj = 0; bj < 2; ++bj) { f32x4 h0, h1, p0, p1; ld8(hin + off + bj * HALF, h0, h1); ld8(P + off + bj * HALF, p0, p1);
                    const float nrs = rs * -1.4426950408889634f;
                    h0 = __builtin_elementwise_fma(sigm4_t(acc[ai][bj][m][0] * nrs), p0, h0); h1 = __builtin_elementwise_fma(sigm4_t(acc[ai][bj][m][1] * nrs), p1, h1);
                    sq += sq4(h0) + sq4(h1);
                    if (LAST) { *(f32x4*)(outf + off + bj * HALF) = h0; *(f32x4*)(outf + off + bj * HALF + 4) = h1; } else st8(hout + off + bj * HALF, h0, h1); }
                sq += __shfl_xor(sq, 16); sq += __shfl_xor(sq, 32);
                if (fq == 0) unsafeAtomicAdd(ssqn + row, sq);
                asm volatile("" ::: "memory"); }
    }
};
struct EpiGateFinal {
    static constexpr bool PERM = true, AFTER_DRAIN = false;
    const bf16_t* hin; const bf16_t* P; float* outf; const float* ssq; float* ssqn; unsigned* cnt; const float* gfin;
    __device__ __forceinline__ void operator()(f32x4 (&acc)[2][2][4][2], const Unit& u, int wr, int wc, int fr, int fq) const {
        const int row0 = u.pm * BM + wr * 64 + fr, col0 = u.pn * BM + wc * 32 + 8 * fq;
#pragma unroll
        for (int ai = 0; ai < 2; ++ai)
#pragma unroll
            for (int m = 0; m < 4; ++m) { const int row = row0 + ai * HALF + m * 16; const float rs = rs_of(ssq[row]); const size_t off = (size_t)row * 1024 + col0; float sq = 0.f;
#pragma unroll
                for (int bj = 0; bj < 2; ++bj) { f32x4 h0, h1, p0, p1; ld8(hin + off + bj * HALF, h0, h1); ld8(P + off + bj * HALF, p0, p1);
                    const float nrs = rs * -1.4426950408889634f;
                    h0 = __builtin_elementwise_fma(sigm4_t(acc[ai][bj][m][0] * nrs), p0, h0); h1 = __builtin_elementwise_fma(sigm4_t(acc[ai][bj][m][1] * nrs), p1, h1);
                    sq += sq4(h0) + sq4(h1); acc[ai][bj][m][0] = h0; acc[ai][bj][m][1] = h1; }
                sq += __shfl_xor(sq, 16); sq += __shfl_xor(sq, 32);
                if (fq == 0) unsafeAtomicAdd(ssqn + row, sq);
                asm volatile("" ::: "memory"); }
        asm volatile("s_waitcnt vmcnt(0)" ::: "memory");
        unsigned* c = cnt + 64 * u.pm;
        if (__builtin_amdgcn_mbcnt_hi(~0u, __builtin_amdgcn_mbcnt_lo(~0u, 0u)) == 0u) __hip_atomic_fetch_add(c, 1u, __ATOMIC_RELAXED, __HIP_MEMORY_SCOPE_AGENT);
        { unsigned spins = 0; while ((unsigned)__builtin_amdgcn_readfirstlane(__hip_atomic_load(c, __ATOMIC_RELAXED, __HIP_MEMORY_SCOPE_AGENT)) < 32u) { if (++spins > (1u << 22)) break; } }
        f32x4 gv[2][2];
#pragma unroll
        for (int bj = 0; bj < 2; ++bj) { gv[bj][0] = *(const f32x4*)(gfin + col0 + bj * HALF); gv[bj][1] = *(const f32x4*)(gfin + col0 + bj * HALF + 4); }
#pragma unroll
        for (int ai = 0; ai < 2; ++ai)
#pragma unroll
            for (int m = 0; m < 4; ++m) { const int row = row0 + ai * HALF + m * 16; const float rs2 = rs_of(__hip_atomic_load(ssqn + row, __ATOMIC_RELAXED, __HIP_MEMORY_SCOPE_AGENT)); float* op = outf + (size_t)row * 1024 + col0;
#pragma unroll
                for (int bj = 0; bj < 2; ++bj) { *(f32x4*)(op + bj * HALF) = acc[ai][bj][m][0] * rs2 * gv[bj][0]; *(f32x4*)(op + bj * HALF + 4) = acc[ai][bj][m][1] * rs2 * gv[bj][1]; } }
    }
};

template <class Epi, class Sched, bool ALIGN_EPI = false, bool SP2 = false, bool HALFN = false>
__device__ __forceinline__ void gemm_phase(PG8_LAS unsigned char* lds, const Gemm g, const Sched& S, const Epi& E, const int wid0) {
    int tid_ = PG8_TIDX(wid0); asm volatile("" : "+v"(tid_));
    const int tid = tid_, wid = __builtin_amdgcn_readfirstlane(tid >> 6), lane = tid & 63, wr = wid >> 2, wc = wid & 3, fr = lane & 15, fq = lane >> 4;
    const int K = g.K, nt = K / BK;
    unsigned voffA[2], voffB[2];
#pragma unroll
    for (int i = 0; i < 2; ++i) { int R, C; stage_rc(tid * 16 + i * 8192, R, C); const int Rb = Epi::PERM ? ((R & ~31) + perm32(R & 31)) : R;
        voffA[i] = (unsigned)(R * K + C) * 2u; voffB[i] = (unsigned)(Rb * K + C) * 2u; }
    const size_t kstep = (size_t)(BK * 2);
    const size_t hstep = (size_t)HALF * K * 2;
    const size_t tstep = 2 * hstep;
    const unsigned ldsw = (unsigned)wid * 1024u;
    const int aoff = lds_byte(wr * 64 + fr, fq * 8), boff = lds_byte(wc * 32 + fr, fq * 8);
#define PG8_SA(b, h) (((b) * 2 + (h)) * HTB)
#define PG8_SB(b, h) ((4 + (b) * 2 + (h)) * HTB)
#define PG8_STAGE(bufoff, gbase, voff) do { _Pragma("unroll") for (int _i = 0; _i < 2; ++_i) \
        __builtin_amdgcn_global_load_lds((const unsigned*)((const char*)(gbase) + (voff)[_i]), (PG8_LAS unsigned*)(lds + (bufoff) + ldsw + _i * 8192), 16, 0, 0); } while (0)
#define PG8_LDA(dst, b, h) do { _Pragma("unroll") for (int m = 0; m < 4; ++m) _Pragma("unroll") for (int k = 0; k < 2; ++k) dst[m][k] = *(const PG8_LAS bf16x8*)(lds + PG8_SA(b, h) + aoff + m * 2048 + k * 1024); } while (0)
#define PG8_LDB(dst, b, h) do { _Pragma("unroll") for (int n = 0; n < 2; ++n) _Pragma("unroll") for (int k = 0; k < 2; ++k) dst[n][k] = *(const PG8_LAS bf16x8*)(lds + PG8_SB(b, h) + boff + n * 2048 + k * 1024); } while (0)
#define PG8_MMA(ai, bj, At, Bt) do { __builtin_amdgcn_s_setprio(1); _Pragma("unroll") for (int m = 0; m < 4; ++m) _Pragma("unroll") for (int n = 0; n < 2; ++n) _Pragma("unroll") for (int k = 0; k < 2; ++k) \
        acc[ai][bj][m][n] = __builtin_amdgcn_mfma_f32_16x16x32_bf16(Bt[n][k], At[m][k], acc[ai][bj][m][n], 0, 0, 0); __builtin_amdgcn_s_setprio(0); } while (0)
#define PG8_WAIT_V(n) asm volatile("s_waitcnt vmcnt(" #n ")" ::: "memory")
#define PG8_WAIT_L(n) asm volatile("s_waitcnt lgkmcnt(" #n ")" ::: "memory")
#define PG8_BAR __builtin_amdgcn_s_barrier()
#define PG8_SCHED __builtin_amdgcn_sched_barrier(0)
    Unit cur, nxt; int ui = 0;
    if (!S.next(0, cur)) return;
    f32x4 acc[2][2][4][2];
#pragma unroll
    for (int a = 0; a < 2; ++a)
#pragma unroll
        for (int b = 0; b < 2; ++b)
#pragma unroll
            for (int m = 0; m < 4; ++m)
#pragma unroll
                for (int n = 0; n < 2; ++n) acc[a][b][m][n] = (f32x4){0.f, 0.f, 0.f, 0.f};
    bf16x8 At[4][2], B0[2][2], B1[2][2];
    const char* cA = (const char*)g.A + (size_t)cur.pm * tstep; const char* cB = (const char*)g.Bt + (size_t)cur.pn * tstep;
    S.a_ready(cur);
    if constexpr (SP2) {
        PG8_STAGE(PG8_SB(0, 0), cB, voffB); PG8_STAGE(PG8_SB(0, 1), cB + hstep, voffB); PG8_STAGE(PG8_SA(0, 0), cA, voffA); PG8_STAGE(PG8_SA(0, 1), cA + hstep, voffA);
        if (wr == 1) PG8_BAR;
        PG8_WAIT_V(2); PG8_BAR;
        PG8_STAGE(PG8_SB(1, 0), cB + kstep, voffB); PG8_STAGE(PG8_SA(1, 0), cA + kstep, voffA); PG8_STAGE(PG8_SB(1, 1), cB + hstep + kstep, voffB);
        PG8_WAIT_V(6); PG8_BAR;
    } else {
        PG8_STAGE(PG8_SB(0, 0), cB, voffB); PG8_STAGE(PG8_SA(0, 0), cA, voffA); PG8_STAGE(PG8_SB(0, 1), cB + hstep, voffB); PG8_STAGE(PG8_SA(0, 1), cA + hstep, voffA);
        if (wr == 1) PG8_BAR;
        PG8_WAIT_V(4); PG8_BAR;
        PG8_STAGE(PG8_SB(1, 0), cB + kstep, voffB); PG8_STAGE(PG8_SA(1, 0), cA + kstep, voffA); PG8_STAGE(PG8_SB(1, 1), cB + hstep + kstep, voffB);
        PG8_WAIT_V(6); PG8_BAR;
    }
    for (;;) {
        const bool has_next = S.next(ui + 1, nxt);
        const char* nA = has_next ? (const char*)g.A + (size_t)nxt.pm * tstep : cA; const char* nB = has_next ? (const char*)g.Bt + (size_t)nxt.pn * tstep : cB;
        for (int t = 0; t < nt; t += 2) {
            const bool last = (t == nt - 2);
            const char* a1 = cA + (size_t)(t + 1) * kstep;
            const char* a2 = last ? nA : cA + (size_t)(t + 2) * kstep; const char* b2 = last ? nB : cB + (size_t)(t + 2) * kstep;
            const char* a3 = a2 + kstep; const char* b3 = b2 + kstep;
            if (last && has_next) S.a_ready(nxt);
            if constexpr (SP2) {
            PG8_LDB(B0, 0, 0); if constexpr (!HALFN) PG8_LDB(B1, 0, 1); PG8_SCHED; PG8_LDA(At, 0, 0); PG8_STAGE(PG8_SA(1, 1), a1 + hstep, voffA);
            PG8_WAIT_V(8); PG8_WAIT_L(0); PG8_BAR; PG8_MMA(0, 0, At, B0); if constexpr (!HALFN) PG8_MMA(0, 1, At, B1); PG8_BAR; PG8_SCHED;
            PG8_LDA(At, 0, 1); PG8_STAGE(PG8_SB(0, 0), b2, voffB); PG8_STAGE(PG8_SB(0, 1), b2 + hstep, voffB); PG8_STAGE(PG8_SA(0, 0), a2, voffA);
            PG8_WAIT_V(8); PG8_WAIT_L(0); PG8_BAR; PG8_MMA(1, 0, At, B0); if constexpr (!HALFN) PG8_MMA(1, 1, At, B1); PG8_BAR; PG8_SCHED;
            PG8_LDB(B0, 1, 0); if constexpr (!HALFN) PG8_LDB(B1, 1, 1); PG8_SCHED; PG8_LDA(At, 1, 0); PG8_STAGE(PG8_SA(0, 1), a2 + hstep, voffA);
            PG8_WAIT_V(8); PG8_WAIT_L(0); PG8_BAR; PG8_MMA(0, 0, At, B0); if constexpr (!HALFN) PG8_MMA(0, 1, At, B1); PG8_BAR; PG8_SCHED;
            PG8_LDA(At, 1, 1); PG8_STAGE(PG8_SB(1, 0), b3, voffB); PG8_STAGE(PG8_SB(1, 1), b3 + hstep, voffB); PG8_STAGE(PG8_SA(1, 0), a3, voffA);
            PG8_WAIT_V(8); PG8_WAIT_L(0); PG8_BAR; PG8_MMA(1, 0, At, B0); if constexpr (!HALFN) PG8_MMA(1, 1, At, B1); PG8_BAR; PG8_SCHED;
            } else {
            PG8_LDB(B0, 0, 0); PG8_SCHED; PG8_LDA(At, 0, 0); PG8_STAGE(PG8_SA(1, 1), a1 + hstep, voffA);
            PG8_WAIT_L(8); PG8_BAR; PG8_WAIT_L(0); PG8_MMA(0, 0, At, B0); PG8_BAR; PG8_SCHED;
            PG8_LDB(B1, 0, 1); PG8_STAGE(PG8_SB(0, 0), b2, voffB);
            PG8_BAR; PG8_WAIT_L(0); PG8_MMA(0, 1, At, B1); PG8_BAR;
            PG8_LDA(At, 0, 1); PG8_STAGE(PG8_SA(0, 0), a2, voffA);
            PG8_BAR; PG8_WAIT_L(0); PG8_MMA(1, 0, At, B0); PG8_BAR; PG8_SCHED;
            PG8_STAGE(PG8_SB(0, 1), b2 + hstep, voffB);
            PG8_WAIT_V(6); PG8_BAR; PG8_MMA(1, 1, At, B1); PG8_BAR;
            PG8_LDB(B0, 1, 0); PG8_SCHED; PG8_LDA(At, 1, 0); PG8_STAGE(PG8_SA(0, 1), a2 + hstep, voffA);
            PG8_WAIT_L(8); PG8_BAR; PG8_WAIT_L(0); PG8_MMA(0, 0, At, B0); PG8_BAR; PG8_SCHED;
            PG8_LDB(B1, 1, 1); PG8_STAGE(PG8_SB(1, 0), b3, voffB);
            PG8_BAR; PG8_WAIT_L(0); PG8_MMA(0, 1, At, B1); PG8_BAR;
            PG8_LDA(At, 1, 1); PG8_STAGE(PG8_SA(1, 0), a3, voffA);
            PG8_BAR; PG8_WAIT_L(0); PG8_MMA(1, 0, At, B0); PG8_BAR; PG8_SCHED;
            PG8_STAGE(PG8_SB(1, 1), b3 + hstep, voffB);
            PG8_WAIT_V(6); PG8_BAR; PG8_MMA(1, 1, At, B1); PG8_BAR;
            }
        }
        if constexpr (ALIGN_EPI) { if (wr == 0) PG8_BAR; }
        if constexpr (!Epi::AFTER_DRAIN) { E(acc, cur, wr, wc, fr, fq); S.done(cur); }
        if (!has_next) break;
#pragma unroll
        for (int a = 0; a < 2; ++a)
#pragma unroll
            for (int b = 0; b < 2; ++b)
#pragma unroll
                for (int m = 0; m < 4; ++m)
#pragma unroll
                    for (int n = 0; n < 2; ++n) acc[a][b][m][n] = (f32x4){0.f, 0.f, 0.f, 0.f};
        cur = nxt; cA = nA; cB = nB; ++ui;
        if constexpr (ALIGN_EPI) { if (wr == 1) PG8_BAR; }
    }
    PG8_WAIT_V(0);
    if constexpr (!ALIGN_EPI) { if (wr == 0) PG8_BAR; }
    PG8_BAR;
    if constexpr (Epi::AFTER_DRAIN) { E.fused(acc, cur, wr, wc, fr, fq, lds, wid, lane); S.done(cur); }
#undef PG8_SA
#undef PG8_SB
#undef PG8_STAGE
#undef PG8_LDA
#undef PG8_LDB
#undef PG8_MMA
#undef PG8_WAIT_V
#undef PG8_WAIT_L
#undef PG8_BAR
#undef PG8_SCHED
}
}

using pg8::bf16_t; using pg8::bf16x8; using pg8::f32x4; using pg8::u32x4;
#define LAS __attribute__((address_space(3)))
#define TIDX(w0) PG8_TIDX(w0)
constexpr int NWAVES = 8, NT = NWAVES * 64;
constexpr int DM = 1024, MP = 16384, MS = 128, MA = MP + MS, SEQ = 2048, NB = 8, DEPTH = 2;
constexpr int DA = 384, DB = 256, DC = 384, DIN = 2176, DINP = 2304, DFF = 4096, DPLE = 256, ZLD = pg8::ZLD;
constexpr int SSQ_STRIDE = 16640;
#ifndef CV_A
#define CV_A 8
#endif
#ifndef CV_B
#define CV_B 18
#endif
constexpr size_t O_Y = 0, O_NAP = (size_t)MA * DM, O_NPP = O_NAP + (size_t)DEPTH * NB * 30 * DA, O_NCP = O_NPP + (size_t)DEPTH * NB * 15 * DB,
                 O_NAS = O_NCP + (size_t)DEPTH * NB * 2 * DC, O_NPS = O_NAS + (size_t)DEPTH * MS * 30 * DA, O_NCS = O_NPS + (size_t)DEPTH * MS * 15 * DB, O_END = O_NCS + (size_t)DEPTH * MS * 2 * DC;
constexpr size_t MiB = 1u << 20;
constexpr size_t WS_SSQ = 0, WS_ZS = 1 * MiB, WS_PS = 3 * MiB, WS_WIN = 4 * MiB, WS_WOUT = 13 * MiB, WS_WUP = 17 * MiB, WS_WDOWN = 33 * MiB, WS_WPG = 49 * MiB, WS_WPP = 53 * MiB,
                 WS_H0 = 54 * MiB, WS_P = 87 * MiB, WS_BIG = 120 * MiB, WS_Z = WS_BIG, WS_U = WS_BIG, WS_END = WS_BIG + 129 * MiB;
static_assert((size_t)MA * DFF * 2 <= 129 * MiB && (size_t)MA * ZLD * 2 <= 129 * MiB && (size_t)MA * DM * 2 <= 33 * MiB && WS_END <= 256 * MiB, "ws map");
constexpr size_t OS_H1 = 0, OS_PB = 34 * MiB;
static_assert(OS_PB + (size_t)DEPTH * MA * DPLE * 2 <= (size_t)MA * DM * 4, "d_out scratch map");
constexpr int LDS_BYTES = 163840, MISC_OFF = 163840 - 256;
constexpr size_t WS_PWT = 3 * MiB + 512 * 1024;
constexpr size_t WS_GRP = 544 * 1024;
constexpr size_t WS_SCNT = WS_GRP + 64 * 256, WS_XID = WS_SCNT + 16 * 256, WS_SLOW = WS_XID + 1024, WS_CTL_END = WS_SLOW + 256;
constexpr size_t WS_CNT = 768 * 1024;
constexpr size_t WS_BAR = 512 * 1024;
static_assert(WS_BAR + 3456 * 4 <= WS_GRP && WS_CTL_END <= WS_CNT, "control words");

struct Params { const float* in[24]; float* out; unsigned char* ws; };
typedef const __attribute__((address_space(4))) Params* KP;
__device__ __forceinline__ KP get_kp() { KP k = (KP)__builtin_amdgcn_kernarg_segment_ptr(); asm volatile("" : "+s"(k)); return k; }
#define WSB(p, off) ((bf16_t*)((p)->ws + (off)))
#define WSF(p, off) ((float*)((p)->ws + (off)))
#define OSB(p, off) ((bf16_t*)((unsigned char*)(p)->out + (off)))
enum { I_XP = 0, I_XS, I_STA, I_STP, I_STC, I_PP, I_PS, I_GMIX, I_WIN, I_CAW, I_CAB, I_LNG, I_LNB, I_POOLW, I_POOLS, I_CCW, I_WOUT, I_GMLP, I_WUP, I_WDOWN, I_GPLE, I_WPG, I_WPP, I_GFIN };

__device__ __forceinline__ float wave_sum(float v) {
#pragma unroll
    for (int o = 1; o < 64; o <<= 1) v += __shfl_xor(v, o);
    return v;
}
__device__ __forceinline__ unsigned f2bf(float f) { unsigned u = __builtin_bit_cast(unsigned, f); return (u + 0x7fffu + ((u >> 16) & 1u)) >> 16; }
__device__ __forceinline__ unsigned pk2(float lo, float hi) { return pg8::cvt_pk_bf16(lo, hi); }
__device__ __forceinline__ float bf2f(bf16_t b) { return __uint_as_float((unsigned)b << 16); }
using pg8::sigm; using pg8::rs_of; using pg8::bf_lo; using pg8::bf_hi;

template <int RT, class Epi>
__device__ __forceinline__ void skinny_gemm(LAS unsigned char* lds, const bf16_t* A, const bf16_t* Bt, int N, int K, int u0, int ustride, const Epi& E, const int wid0) {
    int tid_ = TIDX(wid0); asm volatile("" : "+v"(tid_));
    const int tid = tid_, wid = __builtin_amdgcn_readfirstlane(tid >> 6), lane = tid & 63, i = lane & 15, q = lane >> 4;
    const int ks = K >> 3, kbeg = wid * ks;
    constexpr int NRB = 8 / RT, ROWS = RT * 16;
    LAS float* red = (LAS float*)lds;
    const int nunits = (N >> 4) * NRB;
    for (int unit = u0; unit < nunits; unit += ustride) {
        const int n0 = (unit / NRB) * 16, r0 = (unit % NRB) * ROWS;
        f32x4 acc[RT];
#pragma unroll
        for (int rt = 0; rt < RT; ++rt) acc[rt] = (f32x4){0.f, 0.f, 0.f, 0.f};
        if (ks >= 128) {
            const bf16_t* bp = Bt + (size_t)(n0 + i) * K + kbeg + q * 32;
            const bf16_t* ap = A + (size_t)(r0 + i) * K + kbeg + q * 32;
#pragma unroll 1
            for (int k = 0; k < ks; k += 128) {
                bf16x8 bq[4], aq[RT][4];
#pragma unroll
                for (int s = 0; s < 4; ++s) bq[s] = *(const bf16x8*)(bp + k + 8 * s);
#pragma unroll
                for (int rt = 0; rt < RT; ++rt)
#pragma unroll
                    for (int s = 0; s < 4; ++s) aq[rt][s] = *(const bf16x8*)(ap + (size_t)rt * 16 * K + k + 8 * s);
#pragma unroll
                for (int s = 0; s < 4; ++s)
#pragma unroll
                    for (int rt = 0; rt < RT; ++rt) acc[rt] = __builtin_amdgcn_mfma_f32_16x16x32_bf16(bq[s], aq[rt][s], acc[rt], 0, 0, 0);
            }
        } else {
            const bf16_t* bp = Bt + (size_t)(n0 + i) * K + kbeg + q * 8;
            const bf16_t* ap = A + (size_t)(r0 + i) * K + kbeg + q * 8;
            for (int k = 0; k < ks; k += 32) {
                const bf16x8 b = *(const bf16x8*)(bp + k);
                bf16x8 a[RT];
#pragma unroll
                for (int rt = 0; rt < RT; ++rt) a[rt] = *(const bf16x8*)(ap + (size_t)rt * 16 * K + k);
#pragma unroll
                for (int rt = 0; rt < RT; ++rt) acc[rt] = __builtin_amdgcn_mfma_f32_16x16x32_bf16(b, a[rt], acc[rt], 0, 0, 0);
            }
        }
#pragma unroll
        for (int rt = 0; rt < RT; ++rt) *(LAS f32x4*)(red + ((wid * ROWS + rt * 16 + i) * 16 + 4 * q)) = acc[rt];
        __syncthreads();
        if (tid < ROWS * 4) { const int row = tid >> 2, cq = tid & 3; f32x4 s = (f32x4){0.f, 0.f, 0.f, 0.f};
#pragma unroll
          for (int w = 0; w < 8; ++w) s += *(const LAS f32x4*)(red + ((w * ROWS + row) * 16 + 4 * cq));
          E(r0 + row, n0 + 4 * cq, s); }
        __syncthreads();
    }
}
struct SkZ { float* Zs; const float* ssq; __device__ __forceinline__ void operator()(int r, int c, f32x4 v) const { *(f32x4*)(Zs + (size_t)r * DINP + c) = v * rs_of(ssq[MP + r]); } };
struct SkPlain { float* O; int ld; __device__ __forceinline__ void operator()(int r, int c, f32x4 v) const { *(f32x4*)(O + (size_t)r * ld + c) = v; } };
__device__ __forceinline__ void sk_ssq(float* ssqn, int r, f32x4 h) { float sq = pg8::sq4(h); sq += __shfl_xor(sq, 1); sq += __shfl_xor(sq, 2); if ((__builtin_amdgcn_mbcnt_hi(~0u, __builtin_amdgcn_mbcnt_lo(~0u, 0u)) & 3u) == 0u) unsafeAtomicAdd(ssqn + MP + r, sq); }
__device__ __forceinline__ f32x4 ld4bf(const bf16_t* p) { const uint2 w = *(const uint2*)p; return (f32x4){bf_lo(w.x), bf_hi(w.x), bf_lo(w.y), bf_hi(w.y)}; }
__device__ __forceinline__ void st4bf(bf16_t* p, f32x4 v) { uint2 w; w.x = pk2(v[0], v[1]); w.y = pk2(v[2], v[3]); *(uint2*)p = w; }
__device__ __forceinline__ void st4bf_wt(bf16_t* p, f32x4 v) { const unsigned long long w = (unsigned long long)pk2(v[0], v[1]) | ((unsigned long long)pk2(v[2], v[3]) << 32); __hip_atomic_store((unsigned long long*)p, w, __ATOMIC_RELAXED, __HIP_MEMORY_SCOPE_AGENT); }
struct SkRes { const bf16_t* hin; bf16_t* hout; float* ssqn;
    __device__ __forceinline__ void operator()(int r, int c, f32x4 v) const { const size_t off = (size_t)(MP + r) * DM + c; const f32x4 h = ld4bf(hin + off) + v; st4bf_wt(hout + off, h); sk_ssq(ssqn, r, h); } };
struct SkUp { bf16_t* U; const float* ssq;
    __device__ __forceinline__ void operator()(int r, int c, f32x4 v) const { v = v * rs_of(ssq[MP + r]);
#pragma unroll
        for (int e = 0; e < 4; ++e) { v[e] = fmaxf(v[e], 0.f); v[e] *= v[e]; }
        st4bf_wt(U + (size_t)(MP + r) * DFF + c, v); } };
template <bool LAST> struct SkGate { const bf16_t* hin; const float* Ps; bf16_t* hout; float* outf; const float* ssq; float* ssqn;
    __device__ __forceinline__ void operator()(int r, int c, f32x4 v) const { const size_t off = (size_t)(MP + r) * DM + c; v = v * rs_of(ssq[MP + r]); f32x4 h = ld4bf(hin + off); const f32x4 p = *(const f32x4*)(Ps + (size_t)r * DM + c);
#pragma unroll
        for (int e = 0; e < 4; ++e) h[e] += sigm(v[e]) * p[e];
        if (LAST) { const unsigned long long w0 = (unsigned long long)__float_as_uint(h[0]) | ((unsigned long long)__float_as_uint(h[1]) << 32), w1 = (unsigned long long)__float_as_uint(h[2]) | ((unsigned long long)__float_as_uint(h[3]) << 32);
            __hip_atomic_store((unsigned long long*)(outf + off), w0, __ATOMIC_RELAXED, __HIP_MEMORY_SCOPE_AGENT); __hip_atomic_store((unsigned long long*)(outf + off + 2), w1, __ATOMIC_RELAXED, __HIP_MEMORY_SCOPE_AGENT); }
        else st4bf_wt(hout + off, h);
        sk_ssq(ssqn, r, h); } };

__device__ __forceinline__ void transpose_item(const float* W, int K, int N, bf16_t* WT, int drow0, const float* gain, LAS float* scr, int k0, int n0, int lane) {
    f32x4 v[16];
#pragma unroll
    for (int i = 0; i < 16; ++i) v[i] = *(const f32x4*)(W + (size_t)(k0 + 4 * i + (lane >> 4)) * N + n0 + 4 * (lane & 15));
#pragma unroll
    for (int i = 0; i < 16; ++i) { LAS float* d = scr + (4 * i + (lane >> 4)) * 65 + 4 * (lane & 15); d[0] = v[i][0]; d[1] = v[i][1]; d[2] = v[i][2]; d[3] = v[i][3]; }
    const int c = lane & 7;
    f32x4 g0 = (f32x4){1.f, 1.f, 1.f, 1.f}, g1 = g0;
    if (gain) { g0 = *(const f32x4*)(gain + k0 + 8 * c); g1 = *(const f32x4*)(gain + k0 + 8 * c + 4); }
    asm volatile("s_waitcnt lgkmcnt(0)" ::: "memory");
#pragma unroll
    for (int j = 0; j < 8; ++j) { const int n = (lane >> 3) + 8 * j; const LAS float* s = scr + (8 * c) * 65 + n;
        u32x4 o; o.x = pk2(s[0 * 65] * g0[0], s[1 * 65] * g0[1]); o.y = pk2(s[2 * 65] * g0[2], s[3 * 65] * g0[3]); o.z = pk2(s[4 * 65] * g1[0], s[5 * 65] * g1[1]); o.w = pk2(s[6 * 65] * g1[2], s[7 * 65] * g1[3]);
        *(u32x4*)(WT + (size_t)(drow0 + n) * K + k0 + 8 * c) = o; }
    asm volatile("s_waitcnt lgkmcnt(0)" ::: "memory");
}
__device__ __forceinline__ int win_dest(int n) {
    if (n < 384) return (n >> 7) * 256 + (n & 127);
    if (n < 768) { const int c = n - 384; return (c >> 7) * 256 + 128 + (c & 127); }
    if (n < 1024) return 1536 + (n - 768);
    if (n < 1408) return 1792 + (n - 1024);
    if (n < 1792) { const int c = n - 1408; return (3 + (c >> 7)) * 256 + (c & 127); }
    { const int c = n - 1792; return (3 + (c >> 7)) * 256 + 128 + (c & 127); }
}
__device__ __forceinline__ void convert_layer(KP p, LAS unsigned char* lds, const int l, const int part, const int gw, const int NGW, const int wave, const int lane, const int flo = 0, const int fhi = 64) {
    LAS float* scr = (LAS float*)(lds + wave * 16640);
    constexpr int I_IN = 16 * (DIN / 64), I_SQ = 16 * 16, I_UP = 16 * (DFF / 64), I_DN = 64 * 16, I_PP_ = 4 * 16, I_L = I_IN + I_SQ + I_UP + I_DN + I_SQ + I_PP_;
    const int it_lo0 = (part & 1) ? 0 : I_IN + I_PP_, it_hi0 = (part & 2) ? I_L : I_IN + I_PP_;
    const int it_lo = it_lo0 + (it_hi0 - it_lo0) * flo / 64, it_hi = it_lo0 + (it_hi0 - it_lo0) * fhi / 64;
    for (int it = it_lo + gw; it < it_hi; it += NGW) {
        int r = it;
        if (r < I_IN) { const int nb = DIN / 64, kb = r / nb, n0 = 64 * (r % nb); transpose_item(p->in[I_WIN] + (size_t)l * DM * DIN, DM, DIN, WSB(p, WS_WIN) + (size_t)l * DINP * DM, win_dest(n0), p->in[I_GMIX] + l * DM, scr, 64 * kb, n0, lane); continue; } r -= I_IN;
        if (r < I_PP_) { transpose_item(p->in[I_WPP] + (size_t)l * DPLE * DM, DPLE, DM, WSB(p, WS_WPP) + (size_t)l * DM * DPLE, 64 * (r % 16), nullptr, scr, 64 * (r / 16), 64 * (r % 16), lane); continue; } r -= I_PP_;
        if (r < I_SQ) { transpose_item(p->in[I_WOUT] + (size_t)l * DM * DM, DM, DM, WSB(p, WS_WOUT) + (size_t)l * DM * DM, 64 * (r % 16), nullptr, scr, 64 * (r / 16), 64 * (r % 16), lane); continue; } r -= I_SQ;
        if (r < I_UP) { transpose_item(p->in[I_WUP] + (size_t)l * DM * DFF, DM, DFF, WSB(p, WS_WUP) + (size_t)l * DFF * DM, 64 * (r % 64), p->in[I_GMLP] + l * DM, scr, 64 * (r / 64), 64 * (r % 64), lane); continue; } r -= I_UP;
        if (r < I_DN) { transpose_item(p->in[I_WDOWN] + (size_t)l * DFF * DM, DFF, DM, WSB(p, WS_WDOWN) + (size_t)l * DM * DFF, 64 * (r % 16), nullptr, scr, 64 * (r / 16), 64 * (r % 16), lane); continue; } r -= I_DN;
        if (r < I_SQ) { transpose_item(p->in[I_WPG] + (size_t)l * DM * DM, DM, DM, WSB(p, WS_WPG) + (size_t)l * DM * DM, 64 * (r % 16), p->in[I_GPLE] + l * DM, scr, 64 * (r / 16), 64 * (r % 16), lane); continue; } r -= I_SQ;
    }
    if (!(part & 1)) return;
    for (int it = 128 * flo / 64 + gw; it < 128 * fhi / 64; it += NGW) { const int rr = DIN + it; u32x4* d = (u32x4*)(WSB(p, WS_WIN) + ((size_t)l * DINP + rr) * DM); d[lane] = (u32x4){0u, 0u, 0u, 0u}; d[lane + 64] = (u32x4){0u, 0u, 0u, 0u}; }
    const int m_lo = MA * flo / 64, m_hi = MA * fhi / 64;
    for (int m0 = m_lo + gw; m0 < m_hi; m0 += 8 * NGW) {
        f32x4 v[8];
#pragma unroll
        for (int i = 0; i < 8; ++i) { const int m = m0 + i * NGW; const int mc = m < m_hi ? m : m_hi - 1;
            const float* pr = mc < MP ? p->in[I_PP] + ((size_t)l * MP + mc) * DPLE : p->in[I_PS] + ((size_t)l * MS + (mc - MP)) * DPLE; v[i] = ((const f32x4*)pr)[lane]; }
#pragma unroll
        for (int i = 0; i < 8; ++i) { const int m = m0 + i * NGW; if (m < m_hi) { uint2 w; w.x = pk2(v[i][0], v[i][1]); w.y = pk2(v[i][2], v[i][3]); ((uint2*)(OSB(p, OS_PB) + ((size_t)l * MA + m) * DPLE))[lane] = w; } }
    }
}
__device__ __forceinline__ void prologue(KP p, LAS unsigned char* lds, int bid, int G, const int wid0) {
    int tid_ = TIDX(wid0); asm volatile("" : "+v"(tid_));
    const int tid = tid_, wave = __builtin_amdgcn_readfirstlane(tid >> 6), lane = tid & 63;
    const int gw = bid * NWAVES + wave, NGW = G * NWAVES;
    convert_layer(p, lds, 0, G == 256 ? 1 : 3, gw, NGW, wave, lane);
    if (G != 256) convert_layer(p, lds, 1, 3, gw, NGW, wave, lane);
    for (int m0 = gw; m0 < MA; m0 += 4 * NGW) {
        f32x4 v[4][4];
#pragma unroll
        for (int i = 0; i < 4; ++i) { const int m = m0 + i * NGW; const int mc = m < MA ? m : MA - 1;
            const float* xr = mc < MP ? p->in[I_XP] + (size_t)mc * DM : p->in[I_XS] + (size_t)(mc - MP) * DM;
#pragma unroll
            for (int j = 0; j < 4; ++j) v[i][j] = ((const f32x4*)xr)[lane + 64 * j]; }
#pragma unroll
        for (int i = 0; i < 4; ++i) { const int m = m0 + i * NGW; if (m < MA) { float s = 0.f; uint2* o8 = (uint2*)(WSB(p, WS_H0) + (size_t)m * DM);
#pragma unroll
            for (int j = 0; j < 4; ++j) { s += pg8::sq4(v[i][j]); uint2 w; w.x = pk2(v[i][j][0], v[i][j][1]); w.y = pk2(v[i][j][2], v[i][j][3]); o8[lane + 64 * j] = w; }
            s = wave_sum(s); if (lane == 0) WSF(p, WS_SSQ)[m] = s; } }
    }
    for (int i = bid * NT + tid; i < DEPTH * 4 * 64 * 64; i += G * NT) { const int c = i & 63, d = (i >> 6) & 63, lg_ = i >> 12; WSB(p, WS_PWT)[i] = (bf16_t)f2bf(p->in[I_POOLW][((size_t)lg_ * 64 + c) * 64 + d]); }
    for (int i = bid * NT + tid; i < 64 * 64; i += G * NT) ((unsigned*)(p->ws + WS_CNT))[i] = 0u;
    for (int i = bid * NT + tid; i < 6 * SSQ_STRIDE; i += G * NT) WSF(p, WS_SSQ)[SSQ_STRIDE + i] = 0.f;
}

constexpr int MXL_W = 0, MXL_G = 31 * DA * 4, MXL_P = MXL_G + 94 * DA * 2, MXL_END = MXL_P + 64 * 264 * 2;
constexpr int PLD = 264;
static_assert(MXL_END <= 160 * 1024 - 1024, "mixer LDS map");
__device__ __forceinline__ u32x4 ldg16(const void* p) { return *(const u32x4*)p; }
__device__ __forceinline__ void unpack8(const u32x4 w, float (&f)[8]) { f[0] = bf_lo(w.x); f[1] = bf_hi(w.x); f[2] = bf_lo(w.y); f[3] = bf_hi(w.y); f[4] = bf_lo(w.z); f[5] = bf_hi(w.z); f[6] = bf_lo(w.w); f[7] = bf_hi(w.w); }
__device__ __forceinline__ void mixer_prompt(KP p, bf16_t* MIX, LAS unsigned char* lds, int l, int chunk, const int wid0) {
    int tid_ = TIDX(wid0); asm volatile("" : "+v"(tid_));
    const int tid = tid_, wid = __builtin_amdgcn_readfirstlane(tid >> 6), lane = tid & 63;
    const int b = chunk >> 5, t0 = (chunk & 31) * 64; const size_t rowbase = (size_t)b * SEQ;
    const bf16_t* Zb = WSB(p, WS_Z) + rowbase * ZLD;
    LAS float* WL = (LAS float*)(lds + MXL_W); LAS bf16_t* GL = (LAS bf16_t*)(lds + MXL_G); LAS bf16_t* PL = (LAS bf16_t*)(lds + MXL_P);
    const u32x4 zero4 = (u32x4){0u, 0u, 0u, 0u};
    { const float* cw = p->in[I_CAW] + (size_t)l * 31 * DA;
      u32x4 wv[6], gv[9], xv[19];
#pragma unroll
      for (int i = 0; i < 6; ++i) { const int q = tid + NT * i; wv[i] = q < 31 * 96 ? ldg16(cw + q * 4) : zero4; }
#pragma unroll
      for (int i = 0; i < 9; ++i) { const int q = tid + NT * i, rr = q / 48, cc = q % 48, t = t0 - 30 + rr; const int tc = t > 0 ? t : 0;
          gv[i] = q < 94 * 48 ? ldg16(Zb + (size_t)tc * ZLD + cc * 8) : zero4; if (t < 0) gv[i] = zero4; }
      const int cc = tid & 31, rg = tid >> 5, c0 = cc * 8, w = 2 << (cc >> 3), ts = t0 + rg * 4;
#pragma unroll
      for (int i = 0; i < 19; ++i) { const int t = ts - 15 + i; xv[i] = ldg16(Zb + (size_t)(t > 0 ? t : 0) * ZLD + 384 + c0); if (t < 0 || i < 16 - w) xv[i] = zero4; }
#pragma unroll
      for (int i = 0; i < 6; ++i) { const int q = tid + NT * i; if (q < 31 * 96) *(LAS u32x4*)(WL + q * 4) = wv[i]; }
#pragma unroll
      for (int i = 0; i < 9; ++i) { const int q = tid + NT * i; if (q < 94 * 48) *(LAS u32x4*)(GL + q * 8) = gv[i]; }
      float S[8];
#pragma unroll
      for (int e = 0; e < 8; ++e) S[e] = 0.f;
#pragma unroll
      for (int i = 0; i < 15; ++i) { float f[8]; unpack8(xv[i], f);
#pragma unroll
          for (int e = 0; e < 8; ++e) S[e] += f[e]; }
#pragma unroll
      for (int r = 0; r < 4; ++r) { float cur[8]; unpack8(xv[15 + r], cur); const int t = ts + r; const float icnt = 1.0f / (float)(t + 1 < w ? t + 1 : w); float o[8];
#pragma unroll
          for (int e = 0; e < 8; ++e) { S[e] += cur[e]; o[e] = S[e] * icnt - cur[e]; }
          u32x4 ov; ov.x = pk2(o[0], o[1]); ov.y = pk2(o[2], o[3]); ov.z = pk2(o[4], o[5]); ov.w = pk2(o[6], o[7]);
          *(LAS u32x4*)(PL + (rg * 4 + r) * PLD + c0) = ov;
          u32x4 dv = zero4;
#pragma unroll
          for (int i = 0; i < 19; ++i) if (i == 16 + r - w) dv = xv[i];
          float d[8]; unpack8(dv, d);
#pragma unroll
          for (int e = 0; e < 8; ++e) S[e] -= d[e]; } }
    const float* lg = p->in[I_LNG] + l * DA; const float* lb = p->in[I_LNB] + l * DA; const float* cbias = p->in[I_CAB] + l * DA;
    float lgr[6], lbr[6], cbr[6];
#pragma unroll
    for (int i = 0; i < 6; ++i) { const int c = (i >> 1) * 128 + 2 * lane + (i & 1); lgr[i] = lg[c]; lbr[i] = lb[c]; cbr[i] = cbias[c]; }
    __syncthreads();
    const int c_cc = tid % 48, c_rg = tid / 48, c_c0 = c_cc * 8, c_ts = t0 + (c_rg & 7) * 8;
    u32x4 vv[10], cv[8];
#pragma unroll
    for (int i = 0; i < 10; ++i) { const int t = c_ts - 2 + i; vv[i] = ldg16(Zb + (size_t)(t > 0 ? t : 0) * ZLD + 1024 + c_c0); if (t < 0) vv[i] = zero4; }
#pragma unroll
    for (int i = 0; i < 8; ++i) cv[i] = ldg16(Zb + (size_t)(c_ts + i) * ZLD + 640 + c_c0);
    { typedef float f32x2 __attribute__((ext_vector_type(2)));
      f32x2 a0[3][8];
#pragma unroll
      for (int cb = 0; cb < 3; ++cb) { const int c = cb * 128 + 2 * lane;
          f32x2 w0[31];
#pragma unroll
          for (int k = 0; k < 31; ++k) w0[k] = *(const LAS f32x2*)(WL + k * DA + c);
#pragma unroll
          for (int j = 0; j < 8; ++j) a0[cb][j] = (f32x2){cbr[2 * cb], cbr[2 * cb + 1]};
#pragma unroll
          for (int s = 0; s < 38; ++s) {
              const unsigned gp = *(const LAS unsigned*)(GL + (wid * 8 + s) * DA + c); const f32x2 g0 = (f32x2){bf_lo(gp), bf_hi(gp)};
#pragma unroll
              for (int j = 0; j < 8; ++j) { const int k = s - j; if (k >= 0 && k <= 30) a0[cb][j] = __builtin_elementwise_fma(w0[k], g0, a0[cb][j]); }
          }
          asm volatile("" ::: "memory");
      }
#pragma unroll
      for (int j = 0; j < 8; ++j) { float s = 0.f, ss = 0.f;
#pragma unroll
          for (int cb = 0; cb < 3; ++cb) { s += a0[cb][j].x + a0[cb][j].y; ss += a0[cb][j].x * a0[cb][j].x + a0[cb][j].y * a0[cb][j].y; }
          s = wave_sum(s); ss = wave_sum(ss);
          const float mean = s * (1.0f / DA), rstd = rsqrtf(ss * (1.0f / DA) - mean * mean + 1e-6f);
          bf16_t* mr = MIX + (rowbase + t0 + wid * 8 + j) * DM;
#pragma unroll
          for (int cb = 0; cb < 3; ++cb) { const float y0 = (a0[cb][j].x - mean) * rstd * lgr[2 * cb] + lbr[2 * cb], y1 = (a0[cb][j].y - mean) * rstd * lgr[2 * cb + 1] + lbr[2 * cb + 1];
              *(unsigned*)(mr + cb * 128 + 2 * lane) = pk2(y0 * sigm(y0), y1 * sigm(y1)); } } }
    { const int g = wid & 3, rh = wid >> 2, i = lane & 15, q = lane >> 4; const bf16_t* wt = WSB(p, WS_PWT) + ((size_t)(l * 4 + g) * 64) * 64;
      bf16x8 af[2][2];
#pragma unroll
      for (int rt = 0; rt < 2; ++rt)
#pragma unroll
          for (int ks = 0; ks < 2; ++ks) af[rt][ks] = *(const LAS bf16x8*)(PL + ((rh * 2 + rt) * 16 + i) * PLD + g * 64 + ks * 32 + q * 8);
      const float* psc = p->in[I_POOLS] + l * DB + g * 64;
#pragma unroll
      for (int nt = 0; nt < 4; ++nt) { bf16x8 bfr[2];
#pragma unroll
          for (int ks = 0; ks < 2; ++ks) bfr[ks] = *(const bf16x8*)(wt + (size_t)(nt * 16 + i) * 64 + ks * 32 + q * 8);
          const f32x4 sc = *(const f32x4*)(psc + nt * 16 + 4 * q);
#pragma unroll
          for (int rt = 0; rt < 2; ++rt) { f32x4 acc = (f32x4){0.f, 0.f, 0.f, 0.f};
              acc = __builtin_amdgcn_mfma_f32_16x16x32_bf16(bfr[0], af[rt][0], acc, 0, 0, 0); acc = __builtin_amdgcn_mfma_f32_16x16x32_bf16(bfr[1], af[rt][1], acc, 0, 0, 0);
              st4bf(MIX + (rowbase + t0 + (rh * 2 + rt) * 16 + i) * DM + DA + g * 64 + nt * 16 + 4 * q, acc * sc); } } }
    if (tid < 384) { const float* w3 = p->in[I_CCW] + (size_t)l * 3 * DC + c_c0;
        float wa[8], wb[8], wc_[8];
#pragma unroll
        for (int h = 0; h < 2; ++h) { const f32x4 x0 = *(const f32x4*)(w3 + 4 * h), x1 = *(const f32x4*)(w3 + DC + 4 * h), x2 = *(const f32x4*)(w3 + 2 * DC + 4 * h);
#pragma unroll
            for (int e = 0; e < 4; ++e) { wa[4 * h + e] = x0[e]; wb[4 * h + e] = x1[e]; wc_[4 * h + e] = x2[e]; } }
#pragma unroll
        for (int r = 0; r < 8; ++r) { float f0[8], f1[8], f2[8], fc[8], o[8]; unpack8(vv[r], f0); unpack8(vv[r + 1], f1); unpack8(vv[r + 2], f2); unpack8(cv[r], fc);
#pragma unroll
            for (int e = 0; e < 8; ++e) o[e] = fc[e] * (wa[e] * f0[e] + wb[e] * f1[e] + wc_[e] * f2[e]);
            u32x4 ov; ov.x = pk2(o[0], o[1]); ov.y = pk2(o[2], o[3]); ov.z = pk2(o[4], o[5]); ov.w = pk2(o[6], o[7]);
            *(u32x4*)(MIX + (rowbase + c_ts + r) * DM + DA + DB + c_c0) = ov; } }
    if (t0 == SEQ - 64) {
        float* na = p->out + O_NAP + ((size_t)l * NB + b) * 30 * DA; float* np = p->out + O_NPP + ((size_t)l * NB + b) * 15 * DB; float* nc = p->out + O_NCP + ((size_t)l * NB + b) * 2 * DC;
        u32x4 sv[4]; float* dst[4];
#pragma unroll
        for (int i = 0; i < 4; ++i) { int q = tid + NT * i; const bf16_t* src = Zb; dst[i] = nullptr;
            if (q < 1440) { const int r = q / 48, c8 = (q % 48) * 8; src = Zb + (size_t)(SEQ - 30 + r) * ZLD + c8; dst[i] = na + r * DA + c8; }
            else if (q < 1920) { q -= 1440; const int r = q / 32, c8 = (q % 32) * 8; src = Zb + (size_t)(SEQ - 15 + r) * ZLD + 384 + c8; dst[i] = np + r * DB + c8; }
            else if (q < 2016) { q -= 1920; const int r = q / 48, c8 = (q % 48) * 8; src = Zb + (size_t)(SEQ - 2 + r) * ZLD + 1024 + c8; dst[i] = nc + r * DC + c8; }
            sv[i] = ldg16(src); }
#pragma unroll
        for (int i = 0; i < 4; ++i) if (dst[i]) { float f[8]; unpack8(sv[i], f); *(f32x4*)dst[i] = (f32x4){f[0], f[1], f[2], f[3]}; *(f32x4*)(dst[i] + 4) = (f32x4){f[4], f[5], f[6], f[7]}; }
    }
    __syncthreads();
}
__device__ __forceinline__ void st_bf16_pair_wt(bf16_t* row, int c, float v, int lane) {
    const unsigned me = f2bf(v), other = (unsigned)__shfl_xor((int)me, 1);
    if (!(lane & 1)) __hip_atomic_store((unsigned*)(row + c), me | (other << 16), __ATOMIC_RELAXED, __HIP_MEMORY_SCOPE_AGENT);
}
template <bool DO_A, bool DO_BC>
__device__ __forceinline__ void mixer_sample(KP p, bf16_t* MIX, LAS unsigned char* lds, int l, int j, const int wid0) {
    int tid_ = TIDX(wid0); asm volatile("" : "+v"(tid_));
    const int tid = tid_, wid = __builtin_amdgcn_readfirstlane(tid >> 6), lane = tid & 63;
    const float* z = WSF(p, WS_ZS) + (size_t)j * DINP; bf16_t* mr = MIX + (size_t)(MP + j) * DM;
    LAS float* red = (LAS float*)lds;
    LAS float* pooledL = (LAS float*)(lds + 256);
    float ya = 0.f;
    if (DO_A && tid < DA) {
        const int c = tid, zc = (c >> 7) * 256 + (c & 127); const float* cw = p->in[I_CAW] + (size_t)l * 31 * DA + c; const float* st = p->in[I_STA] + ((size_t)l * MS + j) * 30 * DA + c; float* na = p->out + O_NAS + ((size_t)l * MS + j) * 30 * DA + c;
        float sv[30], wv[31];
#pragma unroll
        for (int k = 0; k < 30; ++k) sv[k] = st[k * DA];
#pragma unroll
        for (int k = 0; k < 31; ++k) wv[k] = cw[k * DA];
        const float glu = z[zc] * sigm(z[zc + 128]); float a = p->in[I_CAB][l * DA + c] + wv[30] * glu;
#pragma unroll
        for (int k = 0; k < 30; ++k) a += wv[k] * sv[k];
#pragma unroll
        for (int k = 1; k < 30; ++k) na[(k - 1) * DA] = sv[k];
        na[29 * DA] = glu; ya = a;
    }
    if (DO_A) { const float s1 = wave_sum(ya), s2 = wave_sum(ya * ya); if (lane == 0) { red[wid] = s1; red[8 + wid] = s2; } }
    if (!DO_BC) {} else if (tid >= 256) {
        for (int c = tid - 256; c < DC; c += 256) { const int zc = (3 + (c >> 7)) * 256 + (c & 127); const float* st = p->in[I_STC] + ((size_t)l * MS + j) * 2 * DC; float* nc = p->out + O_NCS + ((size_t)l * MS + j) * 2 * DC; const float* w3 = p->in[I_CCW] + (size_t)l * 3 * DC;
            const float v = z[zc] * z[zc + 128], s0 = st[c], s1 = st[DC + c]; const float o = z[1792 + c] * (w3[c] * s0 + w3[DC + c] * s1 + w3[2 * DC + c] * v);
            nc[c] = s1; nc[DC + c] = v; st_bf16_pair_wt(mr, DA + DB + c, o, lane); }
    } else {
        const int c = tid, w = 2 << (c >> 6); const float* st = p->in[I_STP] + ((size_t)l * MS + j) * 15 * DB + c; float* np = p->out + O_NPS + ((size_t)l * MS + j) * 15 * DB + c;
        float sv[15];
#pragma unroll
        for (int k = 0; k < 15; ++k) sv[k] = st[k * DB];
        const float cur = z[1536 + c]; float S = cur;
#pragma unroll
        for (int k = 0; k < 15; ++k) if (k >= 16 - w) S += sv[k];
#pragma unroll
        for (int k = 1; k < 15; ++k) np[(k - 1) * DB] = sv[k];
        np[14 * DB] = cur; pooledL[c] = S / (float)w - cur;
    }
    __syncthreads();
    if (DO_A && tid < DA) {
        float s1 = 0.f, s2 = 0.f;
#pragma unroll
        for (int w = 0; w < 6; ++w) { s1 += red[w]; s2 += red[8 + w]; }
        const float mean = s1 * (1.0f / DA), var = s2 * (1.0f / DA) - mean * mean, rstd = rsqrtf(var + 1e-6f);
        const float y = (ya - mean) * rstd * p->in[I_LNG][l * DA + tid] + p->in[I_LNB][l * DA + tid]; st_bf16_pair_wt(mr, tid, y * sigm(y), lane);
    }
    if (DO_BC && tid < DB) {
        const int g = tid >> 6, d = tid & 63; const float* pw = p->in[I_POOLW] + ((size_t)l * 4 + g) * 64 * 64 + d; float o = 0.f;
        float wv[64];
#pragma unroll
        for (int cc = 0; cc < 64; ++cc) wv[cc] = pw[cc * 64];
#pragma unroll
        for (int c4 = 0; c4 < 16; ++c4) { const f32x4 pv = *(const LAS f32x4*)(pooledL + g * 64 + 4 * c4); o += pv[0] * wv[4 * c4] + pv[1] * wv[4 * c4 + 1] + pv[2] * wv[4 * c4 + 2] + pv[3] * wv[4 * c4 + 3]; }
        st_bf16_pair_wt(mr, DA + tid, o * p->in[I_POOLS][l * DB + tid], lane);
    }
    __syncthreads();
}

#define RLX_AGENT __ATOMIC_RELAXED, __HIP_MEMORY_SCOPE_AGENT
#define XB_TMO      128
#define XB_XCNT(j)  (256  + 64 * (j))
#define XB_XSUB(j)  (1280 + 64 * (j))
#define XB_XGEN(j)  (2304 + 64 * (j))
#define XB_TOP      3328
#define XB_TOPGEN   3392
#define XCD_BAR_WORDS 3456
#define XB_SPIN_CAP (1u << 18)

__device__ __forceinline__ unsigned xb_ld(unsigned* p)              { return __hip_atomic_load(p, __ATOMIC_RELAXED, __HIP_MEMORY_SCOPE_AGENT); }
__device__ __forceinline__ unsigned xb_add(unsigned* p, unsigned v) { return __hip_atomic_fetch_add(p, v, __ATOMIC_RELAXED, __HIP_MEMORY_SCOPE_AGENT); }
__device__ __forceinline__ unsigned xb_xcc_id() { return (unsigned)__builtin_amdgcn_s_getreg((3 << 11) | 20) & 0xFu; }
#define XB_SPIN(cond, bar) do { unsigned _sp = 0; while (cond) { \
    if ((++_sp & 255u) == 0u) { if (xb_ld(&(bar)[XB_TMO])) break; if (_sp > XB_SPIN_CAP) { atomicAdd(&(bar)[XB_TMO], 1u); break; } } } } while (0)

struct XcdBarrier {
    unsigned* bar; unsigned x;
    volatile LAS unsigned* st;
};

__device__ __forceinline__ XcdBarrier xcd_barrier_post(unsigned* bar, volatile LAS unsigned* st, const int wid0) {
    XcdBarrier b; b.bar = bar; b.x = xb_xcc_id(); b.st = st;
    if (TIDX(wid0) == 0) (void)xb_add(&bar[XB_XCNT(b.x)], 1u);
    return b;
}
__device__ __forceinline__ void xcd_barrier_complete(unsigned* bar, unsigned x, unsigned& nloc, unsigned& nx) {
    const unsigned G = gridDim.x * gridDim.y * gridDim.z;
    unsigned sum, cnt, mine, sp = 0u;
    for (;;) {
        sum = 0u; cnt = 0u; mine = 0u;
#pragma unroll
        for (unsigned j = 0; j < 16; ++j) { const unsigned c = xb_ld(&bar[XB_XCNT(j)]); sum += c; cnt += (c > 0u) ? 1u : 0u; mine = (j == x) ? c : mine; }
        if (sum == G) break;
        __builtin_amdgcn_s_sleep(1);
        if ((++sp & 255u) == 0u) { if (xb_ld(&bar[XB_TMO])) break; if (sp > XB_SPIN_CAP) { atomicAdd(&bar[XB_TMO], 1u); break; } }
    }
    nloc = mine > 0u ? mine : 1u; nx = cnt > 0u ? cnt : 1u;
}

__device__ __forceinline__ void xcd_barrier(const XcdBarrier& b, const int wid0) {
    asm volatile("s_waitcnt vmcnt(0)" ::: "memory");
    __syncthreads();
    if (TIDX(wid0) == 0) {
        unsigned* bar = b.bar;
        __builtin_amdgcn_s_waitcnt(0);
        unsigned nloc = b.st[0], nx = b.st[1];
        if (nloc == 0u) { xcd_barrier_complete(bar, b.x, nloc, nx); b.st[0] = nloc; b.st[1] = nx; }
        const unsigned old = xb_add(&bar[XB_XSUB(b.x)], 1u);
        const unsigned gen = old / nloc;
        if (old + 1u == (gen + 1u) * nloc) {
            __builtin_amdgcn_fence(__ATOMIC_RELEASE, "agent");
            asm volatile("s_waitcnt vmcnt(0)" ::: "memory");
            const unsigned og = xb_add(&bar[XB_TOP], 1u);
            const unsigned tg = og / nx;
            if (og + 1u == (tg + 1u) * nx) xb_add(&bar[XB_TOPGEN], 1u);
            else XB_SPIN(xb_ld(&bar[XB_TOPGEN]) == tg, bar);
            __builtin_amdgcn_fence(__ATOMIC_ACQUIRE, "agent");
            xb_add(&bar[XB_XGEN(b.x)], 1u);
            asm volatile("s_waitcnt vmcnt(0)" ::: "memory");
        } else {
            XB_SPIN(xb_ld(&bar[XB_XGEN(b.x)]) == gen, bar);
            __builtin_amdgcn_fence(__ATOMIC_ACQUIRE, "agent");
            asm volatile("s_waitcnt vmcnt(0)" ::: "memory");
        }
    }
    __syncthreads();
}

__device__ __forceinline__ void group_barrier(unsigned* gw, unsigned target, unsigned* sw, unsigned starget, const int wid0, unsigned* ex0 = nullptr, unsigned* ex1 = nullptr, unsigned extarget = 0u) {
    asm volatile("s_waitcnt vmcnt(0)" ::: "memory");
    __syncthreads();
    if (TIDX(wid0) == 0) {
        (void)xb_add(gw, 1u);
        unsigned sp = 0; while (xb_ld(gw) < target) { if (++sp > (1u << 24)) break; }
        if (sw) { sp = 0; while (xb_ld(sw) < starget) { if (++sp > (1u << 24)) break; } }
        if (ex0) { sp = 0; while (xb_ld(ex0) < extarget || xb_ld(ex1) < extarget) { if (++sp > (1u << 24)) break; } }
        __builtin_amdgcn_fence(__ATOMIC_ACQUIRE, "agent");
        asm volatile("s_waitcnt vmcnt(0)" ::: "memory");
    }
    __syncthreads();
}
__device__ __forceinline__ void sample_arrive(unsigned* sw, const int wid0) {
    asm volatile("s_waitcnt vmcnt(0)" ::: "memory");
    __syncthreads();
    if (TIDX(wid0) == 0) (void)xb_add(sw, 1u);
}
__device__ __forceinline__ void sample_wait(unsigned* sw, unsigned target, const int wid0) {
    if (TIDX(wid0) == 0) {
        unsigned sp = 0; while (xb_ld(sw) < target) { if (++sp > (1u << 24)) break; }
        __builtin_amdgcn_fence(__ATOMIC_ACQUIRE, "agent");
        asm volatile("s_waitcnt vmcnt(0)" ::: "memory");
    }
    __syncthreads();
}

struct ProjOrder {
    pg8::StaticOrder S; int grp, pm, member;
    __device__ __forceinline__ bool next(int i, pg8::Unit& u) const {
        if (!grp) return S.next(i, u);
        u.pm = pm; if (member == 1) { u.pn = i; return i < 2; } if (member >= 2) { u.pn = member; return i < 1; } return false;
    }
    __device__ __forceinline__ void a_ready(const pg8::Unit&) const {}
    __device__ __forceinline__ void done(const pg8::Unit&) const {}
};

__global__ void __launch_bounds__(NT, 2) fwd_megakernel(Params p_unused) {
    extern __shared__ __attribute__((aligned(16))) unsigned char lds_raw[];
    LAS unsigned char* lds = (LAS unsigned char*)lds_raw;
    cg::grid_group grid = cg::this_grid();
    const int bid = blockIdx.x, G = gridDim.x;
    const int wid0 = __builtin_amdgcn_readfirstlane((int)threadIdx.x >> 6);
    { volatile LAS unsigned* misc = (volatile LAS unsigned*)(lds + MISC_OFF); const int t0_ = TIDX(wid0); if (t0_ < 4) misc[t0_] = 0u; __syncthreads(); }
    if (G == 0x7fffffff) grid.sync();
    XcdBarrier bar;
    { KP p = get_kp(); bar = xcd_barrier_post((unsigned*)(p->ws + WS_BAR), (volatile LAS unsigned*)(lds + MISC_OFF), wid0); }
    if (TIDX(wid0) == 0) { KP p = get_kp(); __hip_atomic_store((unsigned*)(p->ws + WS_XID) + bid, 0x100u | xb_xcc_id(), __ATOMIC_RELAXED, __HIP_MEMORY_SCOPE_AGENT); }
#define GRID_BAR() xcd_barrier(bar, wid0)
#define HCUR(p, l) ((l) == 0 ? WSB(p, WS_H0) : OSB(p, OS_H1))
#define SSQ(p, i) (WSF(p, WS_SSQ) + (i) * SSQ_STRIDE)
#define MIXB(p, l) ((l) == 0 ? OSB(p, OS_H1) : WSB(p, WS_H0))
    { KP p = get_kp(); prologue(p, lds, bid, G, wid0); }
    GRID_BAR();
    if (TIDX(wid0) == 0 && G == 256) { KP p = get_kp(); unsigned* xid = (unsigned*)(p->ws + WS_XID); const unsigned mine = 0x100u | xb_xcc_id(); bool ok = true;
        for (int m = 0; m < 4; ++m) ok = ok && (xb_ld(xid + (bid & 63) + 64 * m) == mine);
        if (!ok) __hip_atomic_store((unsigned*)(p->ws + WS_SLOW), 1u, __ATOMIC_RELAXED, __HIP_MEMORY_SCOPE_AGENT); }
    unsigned gseam = 0, sslot = 0; bool fast_last = false;

#pragma unroll 1
    for (int l = 0; l < DEPTH; ++l) {
        const int off64 = (G > 64) ? 64 : 0;
        { KP p = get_kp(); pg8::Gemm g{HCUR(p, l), WSB(p, WS_WIN) + (size_t)l * DINP * DM, MP, 2048, DM}; pg8::StaticOrder S; S.init(MP, 2048, G, bid); pg8::EpiZ E{WSB(p, WS_Z), SSQ(p, 3 * l), 0};
          pg8::gemm_phase<pg8::EpiZ, pg8::StaticOrder, true, true>(lds, g, S, E, wid0); }
        { KP p = get_kp(); pg8::Gemm g{HCUR(p, l), WSB(p, WS_WIN) + ((size_t)l * DINP + 2048) * DM, MP, 256, DM}; pg8::StaticOrder S; S.init(MP, 256, G, bid); pg8::EpiZ E{WSB(p, WS_Z), SSQ(p, 3 * l), 8};
          pg8::gemm_phase<pg8::EpiZ, pg8::StaticOrder, true, true, true>(lds, g, S, E, wid0); }
        if (bid >= off64) {
            { KP p = get_kp(); int kple = DPLE; asm volatile("" : "+s"(kple));
              pg8::Gemm g{OSB(p, OS_PB) + (size_t)l * MA * DPLE, WSB(p, WS_WPP) + (size_t)l * DM * DPLE, MP, DM, kple};
              ProjOrder S; S.S.init(MP, DM, G - off64, bid - off64); S.grp = (G == 256); S.pm = 8 * (bid & 7) + ((bid >> 3) & 7); S.member = bid >> 6; pg8::EpiPlain E{WSB(p, WS_P), DM};
              pg8::gemm_phase<pg8::EpiPlain, ProjOrder, true, true>(lds, g, S, E, wid0); }
            { KP p = get_kp(); SkZ E{WSF(p, WS_ZS), SSQ(p, 3 * l)}; skinny_gemm<8>(lds, HCUR(p, l) + (size_t)MP * DM, WSB(p, WS_WIN) + (size_t)l * DINP * DM, DINP, DM, bid - off64, G - off64, E, wid0); }
            { KP p = get_kp(); SkPlain E{WSF(p, WS_PS), DM}; skinny_gemm<8>(lds, OSB(p, OS_PB) + ((size_t)l * MA + MP) * DPLE, WSB(p, WS_WPP) + (size_t)l * DM * DPLE, DM, DPLE, (bid - off64 + (G - off64) - 144 % (G - off64)) % (G - off64), G - off64, E, wid0); }
        }
        if (G == 256) { KP p = get_kp(); int tid = TIDX(wid0); asm volatile("" : "+v"(tid)); const int wave = __builtin_amdgcn_readfirstlane(tid >> 6), lane = tid & 63;
            int flo, fhi, gv, NV;
            if (bid < 64) { flo = 0; fhi = CV_A; gv = bid * NWAVES + wave; NV = 64 * NWAVES; }
            else if (bid < 128) { flo = CV_A; fhi = CV_B; gv = (bid - 64) * NWAVES + wave; NV = 64 * NWAVES; }
            else { flo = CV_B; fhi = 64; gv = (bid - 128) * NWAVES + wave; NV = 128 * NWAVES; }
            convert_layer(p, lds, l, 2, gv, NV, wave, lane, flo, fhi); if (l + 1 < DEPTH) convert_layer(p, lds, l + 1, 1, gv, NV, wave, lane, flo, fhi);
        }
        GRID_BAR();
        bool fast; { KP p = get_kp(); fast = (G == 256) && (__builtin_amdgcn_readfirstlane((int)xb_ld((unsigned*)(p->ws + WS_SLOW))) == 0); } fast_last = fast;
#define SEAM() do { if (fast) { KP p_ = get_kp(); ++gseam; group_barrier((unsigned*)(p_->ws + WS_GRP) + 64 * (bid & 63), 4u * gseam, (unsigned*)(p_->ws + WS_SCNT) + 64 * (sslot - 1), (unsigned)G, wid0); } else { GRID_BAR(); } } while (0)
#define S_ARRIVE() do { if (fast) { KP p_ = get_kp(); sample_arrive((unsigned*)(p_->ws + WS_SCNT) + 64 * sslot, wid0); ++sslot; } } while (0)
        for (int it = bid + 256; it < 256 + 2 * MS; it += G) { KP p = get_kp();
            if (it < 256 + MS) mixer_sample<true, false>(p, MIXB(p, l), lds, l, it - 256, wid0);
            else mixer_sample<false, true>(p, MIXB(p, l), lds, l, it - 256 - MS, wid0);
        }
        S_ARRIVE();
        for (int it = bid; it < 256; it += G) { KP p = get_kp();
            mixer_prompt(p, MIXB(p, l), lds, l, G == 256 ? 4 * (8 * (it & 7) + ((it >> 3) & 7)) + (it >> 6) : it, wid0); }
        SEAM();
        const unsigned gs_mix = gseam;
        { KP p = get_kp(); SkRes E{HCUR(p, l), HCUR(p, l), SSQ(p, 3 * l + 1)}; skinny_gemm<2>(lds, MIXB(p, l) + (size_t)MP * DM, WSB(p, WS_WOUT) + (size_t)l * DM * DM, DM, DM, bid, G, E, wid0); }
        S_ARRIVE();
        { KP p = get_kp(); pg8::Gemm g{MIXB(p, l), WSB(p, WS_WOUT) + (size_t)l * DM * DM, MP, DM, DM}; pg8::StaticOrder S; S.init(MP, DM, G, bid); pg8::EpiRes E{HCUR(p, l), HCUR(p, l), SSQ(p, 3 * l + 1)};
          pg8::gemm_phase<pg8::EpiRes, pg8::StaticOrder, true, true>(lds, g, S, E, wid0); }
        if (fast) { KP p_ = get_kp(); ++gseam; unsigned* gb = (unsigned*)(p_->ws + WS_GRP); const int pmA = 8 * (bid & 7) + ((bid >> 3) & 7), qn = pmA + 1; unsigned* nb = (pmA & 7) != 7 ? gb + 64 * ((qn >> 3) + 8 * (qn & 7)) : nullptr;
            group_barrier(gb + 64 * (bid & 63), 4u * gseam, (unsigned*)(p_->ws + WS_SCNT) + 64 * (sslot - 1), (unsigned)G, wid0, nb, nb, 4u * gs_mix); }
        else GRID_BAR();
        { KP p = get_kp(); SkUp E{WSB(p, WS_U), SSQ(p, 3 * l + 1)}; skinny_gemm<8>(lds, HCUR(p, l) + (size_t)MP * DM, WSB(p, WS_WUP) + (size_t)l * DFF * DM, DFF, DM, bid, G, E, wid0); }
        S_ARRIVE();
        { KP p = get_kp(); pg8::Gemm g{HCUR(p, l), WSB(p, WS_WUP) + (size_t)l * DFF * DM, MP, DFF, DM}; pg8::StaticOrder S; S.init(MP, DFF, G, bid); pg8::EpiUp E{WSB(p, WS_U), SSQ(p, 3 * l + 1)};
          pg8::gemm_phase<pg8::EpiUp, pg8::StaticOrder, true, true>(lds, g, S, E, wid0); }
        SEAM();
        { KP p = get_kp(); bf16_t* h5 = (l == DEPTH - 1) ? WSB(p, WS_H0) : HCUR(p, l);
          SkRes E{HCUR(p, l), h5, SSQ(p, 3 * l + 2)}; skinny_gemm<2>(lds, WSB(p, WS_U) + (size_t)MP * DFF, WSB(p, WS_WDOWN) + (size_t)l * DM * DFF, DM, DFF, bid, G, E, wid0); }
        S_ARRIVE();
        { KP p = get_kp(); bf16_t* h5 = (l == DEPTH - 1) ? WSB(p, WS_H0) : HCUR(p, l);
          pg8::Gemm g{WSB(p, WS_U), WSB(p, WS_WDOWN) + (size_t)l * DM * DFF, MP, DM, DFF}; pg8::StaticOrder S; S.init(MP, DM, G, bid); pg8::EpiRes E{HCUR(p, l), h5, SSQ(p, 3 * l + 2)};
          pg8::gemm_phase<pg8::EpiRes, pg8::StaticOrder, true, true>(lds, g, S, E, wid0); }
        if (l == DEPTH - 1 && fast) { KP p_ = get_kp(); ++gseam; unsigned* gb = (unsigned*)(p_->ws + WS_GRP); const int pmA = 8 * (bid & 7) + ((bid >> 3) & 7), q0 = 2 * pmA, q1 = 2 * pmA + 1;
            group_barrier(gb + 64 * (bid & 63), 4u * gseam, (unsigned*)(p_->ws + WS_SCNT) + 64 * (sslot - 1), (unsigned)G, wid0,
                          pmA < 32 ? gb + 64 * ((q0 >> 3) + 8 * (q0 & 7)) : nullptr, pmA < 32 ? gb + 64 * ((q1 >> 3) + 8 * (q1 & 7)) : nullptr, 4u * gseam); }
        else SEAM();
        if (l == DEPTH - 1) {
            { KP p = get_kp(); SkGate<true> E{WSB(p, WS_H0), WSF(p, WS_PS), nullptr, p->out, SSQ(p, 3 * l + 2), SSQ(p, 3 * l + 3)}; skinny_gemm<2>(lds, WSB(p, WS_H0) + (size_t)MP * DM, WSB(p, WS_WPG) + (size_t)l * DM * DM, DM, DM, bid, G, E, wid0); }
            S_ARRIVE();
            if (G == 256) { KP p = get_kp(); pg8::Gemm g{WSB(p, WS_H0), WSB(p, WS_WPG) + (size_t)l * DM * DM, MP, DM, DM}; pg8::StaticOrder S; S.init(MP, DM, G, bid);
              pg8::EpiGateFinal E{WSB(p, WS_H0), WSB(p, WS_P), p->out, SSQ(p, 3 * l + 2), SSQ(p, 3 * l + 3), (unsigned*)(p->ws + WS_CNT), p->in[I_GFIN]};
              pg8::gemm_phase<pg8::EpiGateFinal, pg8::StaticOrder, true, true>(lds, g, S, E, wid0); }
            else { KP p = get_kp(); pg8::Gemm g{WSB(p, WS_H0), WSB(p, WS_WPG) + (size_t)l * DM * DM, MP, DM, DM}; pg8::StaticOrder S; S.init(MP, DM, G, bid);
              pg8::EpiGate<true> E{WSB(p, WS_H0), WSB(p, WS_P), nullptr, p->out, SSQ(p, 3 * l + 2), SSQ(p, 3 * l + 3)};
              pg8::gemm_phase<pg8::EpiGate<true>, pg8::StaticOrder, true, true>(lds, g, S, E, wid0); }
        } else {
            { KP p = get_kp(); SkGate<false> E{WSB(p, WS_H0), WSF(p, WS_PS), OSB(p, OS_H1), nullptr, SSQ(p, 3 * l + 2), SSQ(p, 3 * l + 3)}; skinny_gemm<2>(lds, WSB(p, WS_H0) + (size_t)MP * DM, WSB(p, WS_WPG) + (size_t)l * DM * DM, DM, DM, bid, G, E, wid0); }
            S_ARRIVE();
            { KP p = get_kp(); pg8::Gemm g{WSB(p, WS_H0), WSB(p, WS_WPG) + (size_t)l * DM * DM, MP, DM, DM}; pg8::StaticOrder S; S.init(MP, DM, G, bid); pg8::EpiGate<false> E{WSB(p, WS_H0), WSB(p, WS_P), OSB(p, OS_H1), nullptr, SSQ(p, 3 * l + 2), SSQ(p, 3 * l + 3)};
              pg8::gemm_phase<pg8::EpiGate<false>, pg8::StaticOrder, true, true>(lds, g, S, E, wid0); }
        }
        if (fast) { if (l < DEPTH - 1) SEAM(); } else GRID_BAR();
    }
    if (fast_last) { KP p_ = get_kp(); sample_wait((unsigned*)(p_->ws + WS_SCNT) + 64 * (sslot - 1), (unsigned)G, wid0); }
    { KP p = get_kp(); int tid = TIDX(wid0); asm volatile("" : "+v"(tid)); const int wave = __builtin_amdgcn_readfirstlane(tid >> 6), lane = tid & 63; const float* ssqf = SSQ(p, 6); const f32x4* gf = (const f32x4*)p->in[I_GFIN];
      for (int m = (G == 256 ? MP : 0) + bid * NWAVES + wave; m < MA; m += G * NWAVES) {     const float rs = rs_of(ssqf[m]); f32x4* yr = (f32x4*)(p->out + (size_t)m * DM);
#pragma unroll
          for (int j = 0; j < 4; ++j) { const f32x4 v = yr[lane + 64 * j]; yr[lane + 64 * j] = v * rs * gf[lane + 64 * j]; } } }
}

extern "C" void kernel_launch(void* const* d_in, const int* in_sizes, int n_in, void* d_out, int out_size, void* d_ws, size_t ws_size, hipStream_t stream) {
    static int grid_blocks = 0;
    if (grid_blocks == 0) {
        if (n_in != 24 || (size_t)out_size != O_END || ws_size < WS_END) { fprintf(stderr, "kernel_launch: unexpected shapes: n_in %d out %d ws %zu\n", n_in, out_size, ws_size); grid_blocks = -1; return; }
        int dev = 0, cus = 0, per_cu = 0;
        (void)hipGetDevice(&dev); (void)hipDeviceGetAttribute(&cus, hipDeviceAttributeMultiprocessorCount, dev);
        (void)hipFuncSetAttribute((const void*)fwd_megakernel, hipFuncAttributeMaxDynamicSharedMemorySize, LDS_BYTES);
        (void)hipOccupancyMaxActiveBlocksPerMultiprocessor(&per_cu, (const void*)fwd_megakernel, NT, LDS_BYTES);
        if (per_cu < 1) { fprintf(stderr, "kernel_launch: occupancy query says %d blocks per CU\n", per_cu); per_cu = 1; }
        grid_blocks = cus * (per_cu > 1 ? 1 : per_cu);
    }
    if (grid_blocks < 0) return;
    Params p{};
    for (int i = 0; i < 24; ++i) p.in[i] = (const float*)d_in[i];
    p.out = (float*)d_out; p.ws = (unsigned char*)d_ws;
    (void)hipMemsetAsync((unsigned char*)d_ws + WS_BAR, 0, WS_CTL_END - WS_BAR, stream);
    void* args[] = {&p};
    hipError_t e = hipLaunchCooperativeKernel((const void*)fwd_megakernel, dim3(grid_blocks), dim3(NT), args, LDS_BYTES, stream);
    if (e != hipSuccess) fprintf(stderr, "cooperative launch failed: %s (grid %d)\n", hipGetErrorString(e), grid_blocks);
}
```

```cpp
#include <hip/hip_runtime.h>
#include <hip/hip_cooperative_groups.h>
#include <cstdio>
#include <cstdint>
namespace cg = cooperative_groups;
namespace pg8 {
#define PG8_LAS __attribute__((address_space(3)))
#define PG8_TIDX(w0) ((int)((w0) << 6) + (int)__builtin_amdgcn_mbcnt_hi(~0u, __builtin_amdgcn_mbcnt_lo(~0u, 0u)))
typedef unsigned short bf16_t;
typedef short bf16x8 __attribute__((ext_vector_type(8)));
typedef float f32x4 __attribute__((ext_vector_type(4)));
typedef unsigned u32x4 __attribute__((ext_vector_type(4)));
constexpr int BM = 256, BK = 64, HALF = 128, HTB = HALF * BK * 2  , STAGE_BYTES = 8 * HTB, NXCD = 8, WGM = 8;

__host__ __device__ __forceinline__ int lds_byte(int r, int c) { const int st = (r >> 4) * 2 + (c >> 5), rr = r & 15, cc = c & 31, ob = rr * 64 + cc * 2; return st * 1024 + (ob ^ (((ob >> 9) & 1) << 5)); }
__host__ __device__ __forceinline__ void stage_rc(int b, int& R, int& C) { const int st = b / 1024, sb = b % 1024, swz = sb ^ (((sb >> 9) & 1) << 5); R = (st >> 1) * 16 + swz / 64; C = (st & 1) * 32 + (swz % 64) / 2; }
__host__ __device__ __forceinline__ int perm32(int rho) { const int n = rho >> 4, i = rho & 15; return 8 * (i >> 2) + 4 * n + (i & 3); }

struct Unit { int pm, pn; };
struct Gemm { const bf16_t* A; const bf16_t* Bt; int M, N, K; };

struct StaticOrder {
    int nM, nN, nwg, G, c;
    __host__ __device__ void init(int M, int N, int G_, int c_) { nM = M / BM; nN = N / BM; nwg = nM * nN; G = G_; c = c_; }
    __host__ __device__ bool next(int i, Unit& u) const {
        const long L = (long)i * G + c; if (L >= nwg) return false;
        int wgid = (int)L; { const int q = nwg / NXCD, r = nwg % NXCD, xcd = wgid % NXCD, off = wgid / NXCD; wgid = (xcd < r ? xcd * (q + 1) : r * (q + 1) + (xcd - r) * q) + off; }
        const int nig = WGM * nN, gid = wgid / nig, fm = gid * WGM, gsz = (nM - fm) < WGM ? (nM - fm) : WGM;
        u.pm = fm + ((wgid % nig) % gsz); u.pn = (wgid % nig) / gsz; return true;
    }
    __device__ __forceinline__ void a_ready(const Unit&) const {}
    __device__ __forceinline__ void done(const Unit&) const {}
};

__device__ __forceinline__ unsigned cvt_pk_bf16(float lo, float hi) { unsigned r; asm volatile("v_cvt_pk_bf16_f32 %0, %1, %2" : "=v"(r) : "v"(lo), "v"(hi)); return r; }

constexpr int ZLD = 4096;
__device__ __forceinline__ float sigm(float x) { return __builtin_amdgcn_rcpf(1.0f + __expf(-x)); }
__device__ __forceinline__ f32x4 sigm4_t(const f32x4 t) { f32x4 e; e[0] = __builtin_amdgcn_exp2f(t[0]); e[1] = __builtin_amdgcn_exp2f(t[1]); e[2] = __builtin_amdgcn_exp2f(t[2]); e[3] = __builtin_amdgcn_exp2f(t[3]); const f32x4 d = e + 1.0f; f32x4 r; r[0] = __builtin_amdgcn_rcpf(d[0]); r[1] = __builtin_amdgcn_rcpf(d[1]); r[2] = __builtin_amdgcn_rcpf(d[2]); r[3] = __builtin_amdgcn_rcpf(d[3]); return r; }
__device__ __forceinline__ float rs_of(float ssq) { return rsqrtf(ssq * (1.0f / 1024.0f) + 1e-6f); }
__device__ __forceinline__ float bf_lo(unsigned p) { return __uint_as_float(p << 16); }
__device__ __forceinline__ float bf_hi(unsigned p) { return __uint_as_float(p & 0xffff0000u); }
__device__ __forceinline__ void st8(bf16_t* p, const f32x4 a, const f32x4 b) { u32x4 w; w.x = cvt_pk_bf16(a[0], a[1]); w.y = cvt_pk_bf16(a[2], a[3]); w.z = cvt_pk_bf16(b[0], b[1]); w.w = cvt_pk_bf16(b[2], b[3]); *(u32x4*)p = w; }
__device__ __forceinline__ void ld8(const bf16_t* p, f32x4& a, f32x4& b) { const u32x4 w = *(const u32x4*)p; a = (f32x4){bf_lo(w.x), bf_hi(w.x), bf_lo(w.y), bf_hi(w.y)}; b = (f32x4){bf_lo(w.z), bf_hi(w.z), bf_lo(w.w), bf_hi(w.w)}; }
__device__ __forceinline__ float sq4(const f32x4 a) { return (a[0] * a[0] + a[1] * a[1]) + (a[2] * a[2] + a[3] * a[3]); }

struct EpiZ {
    static constexpr bool PERM = true, AFTER_DRAIN = false;
    bf16_t* Z; const float* ssq; int pn0;
    __device__ __forceinline__ void operator()(const f32x4 (&acc)[2][2][4][2], const Unit& u, int wr, int wc, int fr, int fq) const {
        const int row0 = u.pm * BM + wr * 64 + fr, pn = u.pn + pn0, cl = wc * 32 + 8 * fq;
#pragma unroll
        for (int ai = 0; ai < 2; ++ai)
#pragma unroll
            for (int m = 0; m < 4; ++m) {
                const int row = row0 + ai * HALF + m * 16; const float rs = rs_of(ssq[row]); bf16_t* zr = Z + (size_t)row * ZLD;
                if (pn < 6) {
                    const f32x4 a0 = acc[ai][0][m][0] * rs, a1 = acc[ai][0][m][1] * rs, b0 = acc[ai][1][m][0] * rs, b1 = acc[ai][1][m][1] * rs; f32x4 o0, o1;
                    if (pn < 3) {
                        o0 = a0 * sigm4_t(b0 * -1.4426950408889634f); o1 = a1 * sigm4_t(b1 * -1.4426950408889634f);
                    } else { o0 = a0 * b0; o1 = a1 * b1; }
                    st8(zr + (pn < 3 ? 128 * pn : 1024 + 128 * (pn - 3)) + cl, o0, o1);
                } else {
                    const int cb = pn == 6 ? 384 : (pn == 7 ? 640 : 896);
                    st8(zr + cb + cl, acc[ai][0][m][0] * rs, acc[ai][0][m][1] * rs);
                    if (pn != 8) st8(zr + cb + 128 + cl, acc[ai][1][m][0] * rs, acc[ai][1][m][1] * rs);
                }
            }
    }
};
struct EpiPlain {
    static constexpr bool PERM = true, AFTER_DRAIN = false;
    bf16_t* O; int ldc;
    __device__ __forceinline__ void operator()(const f32x4 (&acc)[2][2][4][2], const Unit& u, int wr, int wc, int fr, int fq) const {
        const int row0 = u.pm * BM + wr * 64 + fr, col0 = u.pn * BM + wc * 32 + 8 * fq;
#pragma unroll
        for (int ai = 0; ai < 2; ++ai)
#pragma unroll
            for (int m = 0; m < 4; ++m) { bf16_t* rp = O + (size_t)(row0 + ai * HALF + m * 16) * ldc + col0;
#pragma unroll
                for (int bj = 0; bj < 2; ++bj) st8(rp + bj * HALF, acc[ai][bj][m][0], acc[ai][bj][m][1]); }
    }
};
struct EpiRes {
    static constexpr bool PERM = true, AFTER_DRAIN = false;
    const bf16_t* hin; bf16_t* hout; float* ssqn;
    __device__ __forceinline__ void operator()(const f32x4 (&acc)[2][2][4][2], const Unit& u, int wr, int wc, int fr, int fq) const {
        const int row0 = u.pm * BM + wr * 64 + fr, col0 = u.pn * BM + wc * 32 + 8 * fq;
#pragma unroll
        for (int ai = 0; ai < 2; ++ai)
#pragma unroll
            for (int m = 0; m < 4; ++m) { const int row = row0 + ai * HALF + m * 16; const size_t off = (size_t)row * 1024 + col0; float sq = 0.f;
#pragma unroll
                for (int bj = 0; bj < 2; ++bj) { f32x4 h0, h1; ld8(hin + off + bj * HALF, h0, h1); h0 += acc[ai][bj][m][0]; h1 += acc[ai][bj][m][1]; sq += sq4(h0) + sq4(h1); st8(hout + off + bj * HALF, h0, h1); }
                sq += __shfl_xor(sq, 16); sq += __shfl_xor(sq, 32);
                if (fq == 0) unsafeAtomicAdd(ssqn + row, sq);
                asm volatile("" ::: "memory"); }
    }
};
struct EpiUp {
    static constexpr bool PERM = true, AFTER_DRAIN = false;
    bf16_t* U; const float* ssq;
    __device__ __forceinline__ void operator()(const f32x4 (&acc)[2][2][4][2], const Unit& u, int wr, int wc, int fr, int fq) const {
        const int row0 = u.pm * BM + wr * 64 + fr, col0 = u.pn * BM + wc * 32 + 8 * fq;
#pragma unroll
        for (int ai = 0; ai < 2; ++ai)
#pragma unroll
            for (int m = 0; m < 4; ++m) { const int row = row0 + ai * HALF + m * 16; const float rs = rs_of(ssq[row]); bf16_t* rp = U + (size_t)row * 4096 + col0;
#pragma unroll
                for (int bj = 0; bj < 2; ++bj) { f32x4 v0 = acc[ai][bj][m][0] * rs, v1 = acc[ai][bj][m][1] * rs;
#pragma unroll
                    for (int e = 0; e < 4; ++e) { v0[e] = fmaxf(v0[e], 0.f); v1[e] = fmaxf(v1[e], 0.f); }
                    st8(rp + bj * HALF, v0 * v0, v1 * v1); } }
    }
};
template <bool LAST> struct EpiGate {
    static constexpr bool PERM = true, AFTER_DRAIN = false;
    const bf16_t* hin; const bf16_t* P; bf16_t* hout; float* outf; const float* ssq; float* ssqn;
    __device__ __forceinline__ void operator()(const f32x4 (&acc)[2][2][4][2], const Unit& u, int wr, int wc, int fr, int fq) const {
        const int row0 = u.pm * BM + wr * 64 + fr, col0 = u.pn * BM + wc * 32 + 8 * fq;
#pragma unroll
        for (int ai = 0; ai < 2; ++ai)
#pragma unroll
            for (int m = 0; m < 4; ++m) { const int row = row0 + ai * HALF + m * 16; const float rs = rs_of(ssq[row]); const size_t off = (size_t)row * 1024 + col0; float sq = 0.f;
#pragma unroll
                for (int bj = 0; bj < 2; ++bj) { f32x4 h0, h1, p0, p1; ld8(hin + off + bj * HALF, h0, h1); ld8(P + off + bj * HALF, p0, p1);
                    const float nrs = rs * -1.4426950408889634f;
                    h0 = __builtin_elementwise_fma(sigm4_t(acc[ai][bj][m][0] * nrs), p0, h0); h1 = __builtin_elementwise_fma(sigm4_t(acc[ai][bj][m][1] * nrs), p1, h1);
                    sq += sq4(h0) + sq4(h1);
                    if (LAST) { *(f32x4*)(outf + off + bj * HALF) = h0; *(f32x4*)(outf + off + bj * HALF + 4) = h1; } else st8(hout + off + bj * HALF, h0, h1); }
                sq += __shfl_xor(sq, 16); sq += __shfl_xor(sq, 32);
                if (fq == 0) unsafeAtomicAdd(ssqn + row, sq);
                asm volatile("" ::: "memory"); }
    }
};
struct EpiGateFinal {
    static constexpr bool PERM = true, AFTER_DRAIN = false;
    const bf16_t* hin; const bf16_t* P; float* outf; const float* ssq; float* ssqn; unsigned* cnt; const float* gfin;
    __device__ __forceinline__ void operator()(f32x4 (&acc)[2][2][4][2], const Unit& u, int wr, int wc, int fr, int fq) const {
        const int row0 = u.pm * BM + wr * 64 + fr, col0 = u.pn * BM + wc * 32 + 8 * fq;
#pragma unroll
        for (int ai = 0; ai < 2; ++ai)
#pragma unroll
            for (int m = 0; m < 4; ++m) { const int row = row0 + ai * HALF + m * 16; const float rs = rs_of(ssq[row]); const size_t off = (size_t)row * 1024 + col0; float sq = 0.f;
#pragma unroll
                for (int bj = 0; bj < 2; ++bj) { f32x4 h0, h1, p0, p1; ld8(hin + off + bj * HALF, h0, h1); ld8(P + off + bj * HALF, p0, p1);
                    const float nrs = rs * -1.4426950408889634f;
                    h0 = __builtin_elementwise_fma(sigm4_t(acc[ai][bj][m][0] * nrs), p0, h0); h1 = __builtin_elementwise_fma(sigm4_t(acc[ai][bj][m][1] * nrs), p1, h1);
                    sq += sq4(h0) + sq4(h1); acc[ai][bj][m][0] = h0; acc[ai][bj][m][1] = h1; }
                sq += __shfl_xor(sq, 16); sq += __shfl_xor(sq, 32);
                if (fq == 0) unsafeAtomicAdd(ssqn + row, sq);
                asm volatile("" ::: "memory"); }
        asm volatile("s_waitcnt vmcnt(0)" ::: "memory");
        unsigned* c = cnt + 64 * u.pm;
        if (__builtin_amdgcn_mbcnt_hi(~0u, __builtin_amdgcn_mbcnt_lo(~0u, 0u)) == 0u) __hip_atomic_fetch_add(c, 1u, __ATOMIC_RELAXED, __HIP_MEMORY_SCOPE_AGENT);
        { unsigned spins = 0; while ((unsigned)__builtin_amdgcn_readfirstlane(__hip_atomic_load(c, __ATOMIC_RELAXED, __HIP_MEMORY_SCOPE_AGENT)) < 32u) { __builtin_amdgcn_s_sleep(2); if (++spins > (1u << 22)) break; } }
        f32x4 gv[2][2];
#pragma unroll
        for (int bj = 0; bj < 2; ++bj) { gv[bj][0] = *(const f32x4*)(gfin + col0 + bj * HALF); gv[bj][1] = *(const f32x4*)(gfin + col0 + bj * HALF + 4); }
#pragma unroll
        for (int ai = 0; ai < 2; ++ai)
#pragma unroll
            for (int m = 0; m < 4; ++m) { const int row = row0 + ai * HALF + m * 16; const float rs2 = rs_of(__hip_atomic_load(ssqn + row, __ATOMIC_RELAXED, __HIP_MEMORY_SCOPE_AGENT)); float* op = outf + (size_t)row * 1024 + col0;
#pragma unroll
                for (int bj = 0; bj < 2; ++bj) { *(f32x4*)(op + bj * HALF) = acc[ai][bj][m][0] * rs2 * gv[bj][0]; *(f32x4*)(op + bj * HALF + 4) = acc[ai][bj][m][1] * rs2 * gv[bj][1]; } }
    }
};

template <class Epi, class Sched, bool ALIGN_EPI = false, bool SP2 = false, bool HALFN = false>
__device__ __forceinline__ void gemm_phase(PG8_LAS unsigned char* lds, const Gemm g, const Sched& S, const Epi& E, const int wid0) {
    int tid_ = PG8_TIDX(wid0); asm volatile("" : "+v"(tid_));
    const int tid = tid_, wid = __builtin_amdgcn_readfirstlane(tid >> 6), lane = tid & 63, wr = wid >> 2, wc = wid & 3, fr = lane & 15, fq = lane >> 4;
    const int K = g.K, nt = K / BK;
    unsigned voffA[2], voffB[2];
#pragma unroll
    for (int i = 0; i < 2; ++i) { int R, C; stage_rc(tid * 16 + i * 8192, R, C); const int Rb = Epi::PERM ? ((R & ~31) + perm32(R & 31)) : R;
        voffA[i] = (unsigned)(R * K + C) * 2u; voffB[i] = (unsigned)(Rb * K + C) * 2u; }
    const size_t kstep = (size_t)(BK * 2);
    const size_t hstep = (size_t)HALF * K * 2;
    const size_t tstep = 2 * hstep;
    const unsigned ldsw = (unsigned)wid * 1024u;
    const int aoff = lds_byte(wr * 64 + fr, fq * 8), boff = lds_byte(wc * 32 + fr, fq * 8);
#define PG8_SA(b, h) (((b) * 2 + (h)) * HTB)
#define PG8_SB(b, h) ((4 + (b) * 2 + (h)) * HTB)
#define PG8_STAGE(bufoff, gbase, voff) do { _Pragma("unroll") for (int _i = 0; _i < 2; ++_i) \
        __builtin_amdgcn_global_load_lds((const unsigned*)((const char*)(gbase) + (voff)[_i]), (PG8_LAS unsigned*)(lds + (bufoff) + ldsw + _i * 8192), 16, 0, 0); } while (0)
#define PG8_LDA(dst, b, h) do { _Pragma("unroll") for (int m = 0; m < 4; ++m) _Pragma("unroll") for (int k = 0; k < 2; ++k) dst[m][k] = *(const PG8_LAS bf16x8*)(lds + PG8_SA(b, h) + aoff + m * 2048 + k * 1024); } while (0)
#define PG8_LDB(dst, b, h) do { _Pragma("unroll") for (int n = 0; n < 2; ++n) _Pragma("unroll") for (int k = 0; k < 2; ++k) dst[n][k] = *(const PG8_LAS bf16x8*)(lds + PG8_SB(b, h) + boff + n * 2048 + k * 1024); } while (0)
#define PG8_MMA(ai, bj, At, Bt) do { __builtin_amdgcn_s_setprio(1); _Pragma("unroll") for (int m = 0; m < 4; ++m) _Pragma("unroll") for (int n = 0; n < 2; ++n) _Pragma("unroll") for (int k = 0; k < 2; ++k) \
        acc[ai][bj][m][n] = __builtin_amdgcn_mfma_f32_16x16x32_bf16(Bt[n][k], At[m][k], acc[ai][bj][m][n], 0, 0, 0); __builtin_amdgcn_s_setprio(0); } while (0)
#define PG8_WAIT_V(n) asm volatile("s_waitcnt vmcnt(" #n ")" ::: "memory")
#define PG8_WAIT_L(n) asm volatile("s_waitcnt lgkmcnt(" #n ")" ::: "memory")
#define PG8_BAR __builtin_amdgcn_s_barrier()
#define PG8_SCHED __builtin_amdgcn_sched_barrier(0)
    Unit cur, nxt; int ui = 0;
    if (!S.next(0, cur)) return;
    f32x4 acc[2][2][4][2];
#pragma unroll
    for (int a = 0; a < 2; ++a)
#pragma unroll
        for (int b = 0; b < 2; ++b)
#pragma unroll
            for (int m = 0; m < 4; ++m)
#pragma unroll
                for (int n = 0; n < 2; ++n) acc[a][b][m][n] = (f32x4){0.f, 0.f, 0.f, 0.f};
    bf16x8 At[4][2], B0[2][2], B1[2][2];
    const char* cA = (const char*)g.A + (size_t)cur.pm * tstep; const char* cB = (const char*)g.Bt + (size_t)cur.pn * tstep;
    S.a_ready(cur);
    if constexpr (SP2) {
        PG8_STAGE(PG8_SB(0, 0), cB, voffB); PG8_STAGE(PG8_SB(0, 1), cB + hstep, voffB); PG8_STAGE(PG8_SA(0, 0), cA, voffA); PG8_STAGE(PG8_SA(0, 1), cA + hstep, voffA);
        if (wr == 1) PG8_BAR;
        PG8_WAIT_V(2); PG8_BAR;
        PG8_STAGE(PG8_SB(1, 0), cB + kstep, voffB); PG8_STAGE(PG8_SA(1, 0), cA + kstep, voffA); PG8_STAGE(PG8_SB(1, 1), cB + hstep + kstep, voffB);
        PG8_WAIT_V(6); PG8_BAR;
    } else {
        PG8_STAGE(PG8_SB(0, 0), cB, voffB); PG8_STAGE(PG8_SA(0, 0), cA, voffA); PG8_STAGE(PG8_SB(0, 1), cB + hstep, voffB); PG8_STAGE(PG8_SA(0, 1), cA + hstep, voffA);
        if (wr == 1) PG8_BAR;
        PG8_WAIT_V(4); PG8_BAR;
        PG8_STAGE(PG8_SB(1, 0), cB + kstep, voffB); PG8_STAGE(PG8_SA(1, 0), cA + kstep, voffA); PG8_STAGE(PG8_SB(1, 1), cB + hstep + kstep, voffB);
        PG8_WAIT_V(6); PG8_BAR;
    }
    for (;;) {
        const bool has_next = S.next(ui + 1, nxt);
        const char* nA = has_next ? (const char*)g.A + (size_t)nxt.pm * tstep : cA; const char* nB = has_next ? (const char*)g.Bt + (size_t)nxt.pn * tstep : cB;
        for (int t = 0; t < nt; t += 2) {
            const bool last = (t == nt - 2);
            const char* a1 = cA + (size_t)(t + 1) * kstep;
            const char* a2 = last ? nA : cA + (size_t)(t + 2) * kstep; const char* b2 = last ? nB : cB + (size_t)(t + 2) * kstep;
            const char* a3 = a2 + kstep; const char* b3 = b2 + kstep;
            if (last && has_next) S.a_ready(nxt);
            if constexpr (SP2) {
            PG8_LDB(B0, 0, 0); if constexpr (!HALFN) PG8_LDB(B1, 0, 1); PG8_SCHED; PG8_LDA(At, 0, 0); PG8_STAGE(PG8_SA(1, 1), a1 + hstep, voffA);
            PG8_WAIT_V(8); PG8_WAIT_L(0); PG8_BAR; PG8_MMA(0, 0, At, B0); if constexpr (!HALFN) PG8_MMA(0, 1, At, B1); PG8_BAR; PG8_SCHED;
            PG8_LDA(At, 0, 1); PG8_STAGE(PG8_SB(0, 0), b2, voffB); PG8_STAGE(PG8_SB(0, 1), b2 + hstep, voffB); PG8_STAGE(PG8_SA(0, 0), a2, voffA);
            PG8_WAIT_V(8); PG8_WAIT_L(0); PG8_BAR; PG8_MMA(1, 0, At, B0); if constexpr (!HALFN) PG8_MMA(1, 1, At, B1); PG8_BAR; PG8_SCHED;
            PG8_LDB(B0, 1, 0); if constexpr (!HALFN) PG8_LDB(B1, 1, 1); PG8_SCHED; PG8_LDA(At, 1, 0); PG8_STAGE(PG8_SA(0, 1), a2 + hstep, voffA);
            PG8_WAIT_V(8); PG8_WAIT_L(0); PG8_BAR; PG8_MMA(0, 0, At, B0); if constexpr (!HALFN) PG8_MMA(0, 1, At, B1); PG8_BAR; PG8_SCHED;
            PG8_LDA(At, 1, 1); PG8_STAGE(PG8_SB(1, 0), b3, voffB); PG8_STAGE(PG8_SB(1, 1), b3 + hstep, voffB); PG8_STAGE(PG8_SA(1, 0), a3, voffA);
            PG8_WAIT_V(8); PG8_WAIT_L(0); PG8_BAR; PG8_MMA(1, 0, At, B0); if constexpr (!HALFN) PG8_MMA(1, 1, At, B1); PG8_BAR; PG8_SCHED;
            } else {
            PG8_LDB(B0, 0, 0); PG8_SCHED; PG8_LDA(At, 0, 0); PG8_STAGE(PG8_SA(1, 1), a1 + hstep, voffA);
            PG8_WAIT_L(8); PG8_BAR; PG8_WAIT_L(0); PG8_MMA(0, 0, At, B0); PG8_BAR; PG8_SCHED;
            PG8_LDB(B1, 0, 1); PG8_STAGE(PG8_SB(0, 0), b2, voffB);
            PG8_BAR; PG8_WAIT_L(0); PG8_MMA(0, 1, At, B1); PG8_BAR;
            PG8_LDA(At, 0, 1); PG8_STAGE(PG8_SA(0, 0), a2, voffA);
            PG8_BAR; PG8_WAIT_L(0); PG8_MMA(1, 0, At, B0); PG8_BAR; PG8_SCHED;
            PG8_STAGE(PG8_SB(0, 1), b2 + hstep, voffB);
            PG8_WAIT_V(6); PG8_BAR; PG8_MMA(1, 1, At, B1); PG8_BAR;
            PG8_LDB(B0, 1, 0); PG8_SCHED; PG8_LDA(At, 1, 0); PG8_STAGE(PG8_SA(0, 1), a2 + hstep, voffA);
            PG8_WAIT_L(8); PG8_BAR; PG8_WAIT_L(0); PG8_MMA(0, 0, At, B0); PG8_BAR; PG8_SCHED;
            PG8_LDB(B1, 1, 1); PG8_STAGE(PG8_SB(1, 0), b3, voffB);
            PG8_BAR; PG8_WAIT_L(0); PG8_MMA(0, 1, At, B1); PG8_BAR;
            PG8_LDA(At, 1, 1); PG8_STAGE(PG8_SA(1, 0), a3, voffA);
            PG8_BAR; PG8_WAIT_L(0); PG8_MMA(1, 0, At, B0); PG8_BAR; PG8_SCHED;
            PG8_STAGE(PG8_SB(1, 1), b3 + hstep, voffB);
            PG8_WAIT_V(6); PG8_BAR; PG8_MMA(1, 1, At, B1); PG8_BAR;
            }
        }
        if constexpr (ALIGN_EPI) { if (wr == 0) PG8_BAR; }
        if constexpr (!Epi::AFTER_DRAIN) { E(acc, cur, wr, wc, fr, fq); S.done(cur); }
        if (!has_next) break;
#pragma unroll
        for (int a = 0; a < 2; ++a)
#pragma unroll
            for (int b = 0; b < 2; ++b)
#pragma unroll
                for (int m = 0; m < 4; ++m)
#pragma unroll
                    for (int n = 0; n < 2; ++n) acc[a][b][m][n] = (f32x4){0.f, 0.f, 0.f, 0.f};
        cur = nxt; cA = nA; cB = nB; ++ui;
        if constexpr (ALIGN_EPI) { if (wr == 1) PG8_BAR; }
    }
    PG8_WAIT_V(0);
    if constexpr (!ALIGN_EPI) { if (wr == 0) PG8_BAR; }
    PG8_BAR;
    if constexpr (Epi::AFTER_DRAIN) { E.fused(acc, cur, wr, wc, fr, fq, lds, wid, lane); S.done(cur); }
#undef PG8_SA
#undef PG8_SB
#undef PG8_STAGE
#undef PG8_LDA
#undef PG8_LDB
#undef PG8_MMA
#undef PG8_WAIT_V
#undef PG8_WAIT_L
#undef PG8_BAR
#undef PG8_SCHED
}
}

using pg8::bf16_t; using pg8::bf16x8; using pg8::f32x4; using pg8::u32x4;
#define LAS __attribute__((address_space(3)))
#define TIDX(w0) PG8_TIDX(w0)
constexpr int NWAVES = 8, NT = NWAVES * 64;
constexpr int DM = 1024, MP = 16384, MS = 128, MA = MP + MS, SEQ = 2048, NB = 8, DEPTH = 2;
constexpr int DA = 384, DB = 256, DC = 384, DIN = 2176, DINP = 2304, DFF = 4096, DPLE = 256, ZLD = pg8::ZLD;
constexpr int SSQ_STRIDE = 16640;
#ifndef CV_A
#define CV_A 8
#endif
#ifndef CV_B
#define CV_B 18
#endif
constexpr size_t O_Y = 0, O_NAP = (size_t)MA * DM, O_NPP = O_NAP + (size_t)DEPTH * NB * 30 * DA, O_NCP = O_NPP + (size_t)DEPTH * NB * 15 * DB,
                 O_NAS = O_NCP + (size_t)DEPTH * NB * 2 * DC, O_NPS = O_NAS + (size_t)DEPTH * MS * 30 * DA, O_NCS = O_NPS + (size_t)DEPTH * MS * 15 * DB, O_END = O_NCS + (size_t)DEPTH * MS * 2 * DC;
constexpr size_t MiB = 1u << 20;
constexpr size_t WS_SSQ = 0, WS_ZS = 1 * MiB, WS_PS = 3 * MiB, WS_WIN = 4 * MiB, WS_WOUT = 13 * MiB, WS_WUP = 17 * MiB, WS_WDOWN = 33 * MiB, WS_WPG = 49 * MiB, WS_WPP = 53 * MiB,
                 WS_H0 = 54 * MiB, WS_P = 87 * MiB, WS_BIG = 120 * MiB, WS_Z = WS_BIG, WS_U = WS_BIG, WS_END = WS_BIG + 129 * MiB;
static_assert((size_t)MA * DFF * 2 <= 129 * MiB && (size_t)MA * ZLD * 2 <= 129 * MiB && (size_t)MA * DM * 2 <= 33 * MiB && WS_END <= 256 * MiB, "ws map");
constexpr size_t OS_H1 = 0, OS_PB = 34 * MiB;
static_assert(OS_PB + (size_t)DEPTH * MA * DPLE * 2 <= (size_t)MA * DM * 4, "d_out scratch map");
constexpr int LDS_BYTES = 163840, MISC_OFF = 163840 - 256;
constexpr size_t WS_PWT = 3 * MiB + 512 * 1024;
constexpr size_t WS_GRP = 544 * 1024;
constexpr size_t WS_SCNT = WS_GRP + 64 * 256, WS_XID = WS_SCNT + 16 * 256, WS_SLOW = WS_XID + 1024, WS_CTL_END = WS_SLOW + 256;
constexpr size_t WS_CNT = 768 * 1024;
constexpr size_t WS_BAR = 512 * 1024;
static_assert(WS_BAR + 3456 * 4 <= WS_GRP && WS_CTL_END <= WS_CNT, "control words");

struct Params { const float* in[24]; float* out; unsigned char* ws; };
typedef const __attribute__((address_space(4))) Params* KP;
__device__ __forceinline__ KP get_kp() { KP k = (KP)__builtin_amdgcn_kernarg_segment_ptr(); asm volatile("" : "+s"(k)); return k; }
#define WSB(p, off) ((bf16_t*)((p)->ws + (off)))
#define WSF(p, off) ((float*)((p)->ws + (off)))
#define OSB(p, off) ((bf16_t*)((unsigned char*)(p)->out + (off)))
enum { I_XP = 0, I_XS, I_STA, I_STP, I_STC, I_PP, I_PS, I_GMIX, I_WIN, I_CAW, I_CAB, I_LNG, I_LNB, I_POOLW, I_POOLS, I_CCW, I_WOUT, I_GMLP, I_WUP, I_WDOWN, I_GPLE, I_WPG, I_WPP, I_GFIN };

__device__ __forceinline__ float wave_sum(float v) {
#pragma unroll
    for (int o = 1; o < 64; o <<= 1) v += __shfl_xor(v, o);
    return v;
}
__device__ __forceinline__ unsigned f2bf(float f) { unsigned u = __builtin_bit_cast(unsigned, f); return (u + 0x7fffu + ((u >> 16) & 1u)) >> 16; }
__device__ __forceinline__ unsigned pk2(float lo, float hi) { return pg8::cvt_pk_bf16(lo, hi); }
__device__ __forceinline__ float bf2f(bf16_t b) { return __uint_as_float((unsigned)b << 16); }
using pg8::sigm; using pg8::rs_of; using pg8::bf_lo; using pg8::bf_hi;

template <int RT, class Epi>
__device__ __forceinline__ void skinny_gemm(LAS unsigned char* lds, const bf16_t* A, const bf16_t* Bt, int N, int K, int u0, int ustride, const Epi& E, const int wid0) {
    int tid_ = TIDX(wid0); asm volatile("" : "+v"(tid_));
    const int tid = tid_, wid = __builtin_amdgcn_readfirstlane(tid >> 6), lane = tid & 63, i = lane & 15, q = lane >> 4;
    const int ks = K >> 3, kbeg = wid * ks;
    constexpr int NRB = 8 / RT, ROWS = RT * 16;
    LAS float* red = (LAS float*)lds;
    const int nunits = (N >> 4) * NRB;
    for (int unit = u0; unit < nunits; unit += ustride) {
        const int n0 = (unit / NRB) * 16, r0 = (unit % NRB) * ROWS;
        f32x4 acc[RT];
#pragma unroll
        for (int rt = 0; rt < RT; ++rt) acc[rt] = (f32x4){0.f, 0.f, 0.f, 0.f};
        if (ks >= 128) {
            const bf16_t* bp = Bt + (size_t)(n0 + i) * K + kbeg + q * 32;
            const bf16_t* ap = A + (size_t)(r0 + i) * K + kbeg + q * 32;
#pragma unroll 1
            for (int k = 0; k < ks; k += 128) {
                bf16x8 bq[4], aq[RT][4];
#pragma unroll
                for (int s = 0; s < 4; ++s) bq[s] = *(const bf16x8*)(bp + k + 8 * s);
#pragma unroll
                for (int rt = 0; rt < RT; ++rt)
#pragma unroll
                    for (int s = 0; s < 4; ++s) aq[rt][s] = *(const bf16x8*)(ap + (size_t)rt * 16 * K + k + 8 * s);
#pragma unroll
                for (int s = 0; s < 4; ++s)
#pragma unroll
                    for (int rt = 0; rt < RT; ++rt) acc[rt] = __builtin_amdgcn_mfma_f32_16x16x32_bf16(bq[s], aq[rt][s], acc[rt], 0, 0, 0);
            }
        } else {
            const bf16_t* bp = Bt + (size_t)(n0 + i) * K + kbeg + q * 8;
            const bf16_t* ap = A + (size_t)(r0 + i) * K + kbeg + q * 8;
            for (int k = 0; k < ks; k += 32) {
                const bf16x8 b = *(const bf16x8*)(bp + k);
                bf16x8 a[RT];
#pragma unroll
                for (int rt = 0; rt < RT; ++rt) a[rt] = *(const bf16x8*)(ap + (size_t)rt * 16 * K + k);
#pragma unroll
                for (int rt = 0; rt < RT; ++rt) acc[rt] = __builtin_amdgcn_mfma_f32_16x16x32_bf16(b, a[rt], acc[rt], 0, 0, 0);
            }
        }
#pragma unroll
        for (int rt = 0; rt < RT; ++rt) *(LAS f32x4*)(red + ((wid * ROWS + rt * 16 + i) * 16 + 4 * q)) = acc[rt];
        __syncthreads();
        if (tid < ROWS * 4) { const int row = tid >> 2, cq = tid & 3; f32x4 s = (f32x4){0.f, 0.f, 0.f, 0.f};
#pragma unroll
          for (int w = 0; w < 8; ++w) s += *(const LAS f32x4*)(red + ((w * ROWS + row) * 16 + 4 * cq));
          E(r0 + row, n0 + 4 * cq, s); }
        __syncthreads();
    }
}
struct SkZ { float* Zs; const float* ssq; __device__ __forceinline__ void operator()(int r, int c, f32x4 v) const { *(f32x4*)(Zs + (size_t)r * DINP + c) = v * rs_of(ssq[MP + r]); } };
struct SkPlain { float* O; int ld; __device__ __forceinline__ void operator()(int r, int c, f32x4 v) const { *(f32x4*)(O + (size_t)r * ld + c) = v; } };
__device__ __forceinline__ void sk_ssq(float* ssqn, int r, f32x4 h) { float sq = pg8::sq4(h); sq += __shfl_xor(sq, 1); sq += __shfl_xor(sq, 2); if ((__builtin_amdgcn_mbcnt_hi(~0u, __builtin_amdgcn_mbcnt_lo(~0u, 0u)) & 3u) == 0u) unsafeAtomicAdd(ssqn + MP + r, sq); }
__device__ __forceinline__ f32x4 ld4bf(const bf16_t* p) { const uint2 w = *(const uint2*)p; return (f32x4){bf_lo(w.x), bf_hi(w.x), bf_lo(w.y), bf_hi(w.y)}; }
__device__ __forceinline__ void st4bf(bf16_t* p, f32x4 v) { uint2 w; w.x = pk2(v[0], v[1]); w.y = pk2(v[2], v[3]); *(uint2*)p = w; }
__device__ __forceinline__ void st4bf_wt(bf16_t* p, f32x4 v) { const unsigned long long w = (unsigned long long)pk2(v[0], v[1]) | ((unsigned long long)pk2(v[2], v[3]) << 32); __hip_atomic_store((unsigned long long*)p, w, __ATOMIC_RELAXED, __HIP_MEMORY_SCOPE_AGENT); }
struct SkRes { const bf16_t* hin; bf16_t* hout; float* ssqn;
    __device__ __forceinline__ void operator()(int r, int c, f32x4 v) const { const size_t off = (size_t)(MP + r) * DM + c; const f32x4 h = ld4bf(hin + off) + v; st4bf_wt(hout + off, h); sk_ssq(ssqn, r, h); } };
struct SkUp { bf16_t* U; const float* ssq;
    __device__ __forceinline__ void operator()(int r, int c, f32x4 v) const { v = v * rs_of(ssq[MP + r]);
#pragma unroll
        for (int e = 0; e < 4; ++e) { v[e] = fmaxf(v[e], 0.f); v[e] *= v[e]; }
        st4bf_wt(U + (size_t)(MP + r) * DFF + c, v); } };
template <bool LAST> struct SkGate { const bf16_t* hin; const float* Ps; bf16_t* hout; float* outf; const float* ssq; float* ssqn;
    __device__ __forceinline__ void operator()(int r, int c, f32x4 v) const { const size_t off = (size_t)(MP + r) * DM + c; v = v * rs_of(ssq[MP + r]); f32x4 h = ld4bf(hin + off); const f32x4 p = *(const f32x4*)(Ps + (size_t)r * DM + c);
#pragma unroll
        for (int e = 0; e < 4; ++e) h[e] += sigm(v[e]) * p[e];
        if (LAST) { const unsigned long long w0 = (unsigned long long)__float_as_uint(h[0]) | ((unsigned long long)__float_as_uint(h[1]) << 32), w1 = (unsigned long long)__float_as_uint(h[2]) | ((unsigned long long)__float_as_uint(h[3]) << 32);
            __hip_atomic_store((unsigned long long*)(outf + off), w0, __ATOMIC_RELAXED, __HIP_MEMORY_SCOPE_AGENT); __hip_atomic_store((unsigned long long*)(outf + off + 2), w1, __ATOMIC_RELAXED, __HIP_MEMORY_SCOPE_AGENT); }
        else st4bf_wt(hout + off, h);
        sk_ssq(ssqn, r, h); } };

__device__ __forceinline__ void transpose_item(const float* W, int K, int N, bf16_t* WT, int drow0, const float* gain, LAS float* scr, int k0, int n0, int lane) {
    f32x4 v[16];
#pragma unroll
    for (int i = 0; i < 16; ++i) v[i] = *(const f32x4*)(W + (size_t)(k0 + 4 * i + (lane >> 4)) * N + n0 + 4 * (lane & 15));
#pragma unroll
    for (int i = 0; i < 16; ++i) { LAS float* d = scr + (4 * i + (lane >> 4)) * 65 + 4 * (lane & 15); d[0] = v[i][0]; d[1] = v[i][1]; d[2] = v[i][2]; d[3] = v[i][3]; }
    const int c = lane & 7;
    f32x4 g0 = (f32x4){1.f, 1.f, 1.f, 1.f}, g1 = g0;
    if (gain) { g0 = *(const f32x4*)(gain + k0 + 8 * c); g1 = *(const f32x4*)(gain + k0 + 8 * c + 4); }
    asm volatile("s_waitcnt lgkmcnt(0)" ::: "memory");
#pragma unroll
    for (int j = 0; j < 8; ++j) { const int n = (lane >> 3) + 8 * j; const LAS float* s = scr + (8 * c) * 65 + n;
        u32x4 o; o.x = pk2(s[0 * 65] * g0[0], s[1 * 65] * g0[1]); o.y = pk2(s[2 * 65] * g0[2], s[3 * 65] * g0[3]); o.z = pk2(s[4 * 65] * g1[0], s[5 * 65] * g1[1]); o.w = pk2(s[6 * 65] * g1[2], s[7 * 65] * g1[3]);
        *(u32x4*)(WT + (size_t)(drow0 + n) * K + k0 + 8 * c) = o; }
    asm volatile("s_waitcnt lgkmcnt(0)" ::: "memory");
}
__device__ __forceinline__ int win_dest(int n) {
    if (n < 384) return (n >> 7) * 256 + (n & 127);
    if (n < 768) { const int c = n - 384; return (c >> 7) * 256 + 128 + (c & 127); }
    if (n < 1024) return 1536 + (n - 768);
    if (n < 1408) return 1792 + (n - 1024);
    if (n < 1792) { const int c = n - 1408; return (3 + (c >> 7)) * 256 + (c & 127); }
    { const int c = n - 1792; return (3 + (c >> 7)) * 256 + 128 + (c & 127); }
}
__device__ __forceinline__ void convert_layer(KP p, LAS unsigned char* lds, const int l, const int part, const int gw, const int NGW, const int wave, const int lane, const int flo = 0, const int fhi = 64) {
    LAS float* scr = (LAS float*)(lds + wave * 16640);
    constexpr int I_IN = 16 * (DIN / 64), I_SQ = 16 * 16, I_UP = 16 * (DFF / 64), I_DN = 64 * 16, I_PP_ = 4 * 16, I_L = I_IN + I_SQ + I_UP + I_DN + I_SQ + I_PP_;
    const int it_lo0 = (part & 1) ? 0 : I_IN + I_PP_, it_hi0 = (part & 2) ? I_L : I_IN + I_PP_;
    const int it_lo = it_lo0 + (it_hi0 - it_lo0) * flo / 64, it_hi = it_lo0 + (it_hi0 - it_lo0) * fhi / 64;
    for (int it = it_lo + gw; it < it_hi; it += NGW) {
        int r = it;
        if (r < I_IN) { const int nb = DIN / 64, kb = r / nb, n0 = 64 * (r % nb); transpose_item(p->in[I_WIN] + (size_t)l * DM * DIN, DM, DIN, WSB(p, WS_WIN) + (size_t)l * DINP * DM, win_dest(n0), p->in[I_GMIX] + l * DM, scr, 64 * kb, n0, lane); continue; } r -= I_IN;
        if (r < I_PP_) { transpose_item(p->in[I_WPP] + (size_t)l * DPLE * DM, DPLE, DM, WSB(p, WS_WPP) + (size_t)l * DM * DPLE, 64 * (r % 16), nullptr, scr, 64 * (r / 16), 64 * (r % 16), lane); continue; } r -= I_PP_;
        if (r < I_SQ) { transpose_item(p->in[I_WOUT] + (size_t)l * DM * DM, DM, DM, WSB(p, WS_WOUT) + (size_t)l * DM * DM, 64 * (r % 16), nullptr, scr, 64 * (r / 16), 64 * (r % 16), lane); continue; } r -= I_SQ;
        if (r < I_UP) { transpose_item(p->in[I_WUP] + (size_t)l * DM * DFF, DM, DFF, WSB(p, WS_WUP) + (size_t)l * DFF * DM, 64 * (r % 64), p->in[I_GMLP] + l * DM, scr, 64 * (r / 64), 64 * (r % 64), lane); continue; } r -= I_UP;
        if (r < I_DN) { transpose_item(p->in[I_WDOWN] + (size_t)l * DFF * DM, DFF, DM, WSB(p, WS_WDOWN) + (size_t)l * DM * DFF, 64 * (r % 16), nullptr, scr, 64 * (r / 16), 64 * (r % 16), lane); continue; } r -= I_DN;
        if (r < I_SQ) { transpose_item(p->in[I_WPG] + (size_t)l * DM * DM, DM, DM, WSB(p, WS_WPG) + (size_t)l * DM * DM, 64 * (r % 16), p->in[I_GPLE] + l * DM, scr, 64 * (r / 16), 64 * (r % 16), lane); continue; } r -= I_SQ;
    }
    if (!(part & 1)) return;
    for (int it = 128 * flo / 64 + gw; it < 128 * fhi / 64; it += NGW) { const int rr = DIN + it; u32x4* d = (u32x4*)(WSB(p, WS_WIN) + ((size_t)l * DINP + rr) * DM); d[lane] = (u32x4){0u, 0u, 0u, 0u}; d[lane + 64] = (u32x4){0u, 0u, 0u, 0u}; }
    const int m_lo = MA * flo / 64, m_hi = MA * fhi / 64;
    for (int m0 = m_lo + gw; m0 < m_hi; m0 += 8 * NGW) {
        f32x4 v[8];
#pragma unroll
        for (int i = 0; i < 8; ++i) { const int m = m0 + i * NGW; const int mc = m < m_hi ? m : m_hi - 1;
            const float* pr = mc < MP ? p->in[I_PP] + ((size_t)l * MP + mc) * DPLE : p->in[I_PS] + ((size_t)l * MS + (mc - MP)) * DPLE; v[i] = ((const f32x4*)pr)[lane]; }
#pragma unroll
        for (int i = 0; i < 8; ++i) { const int m = m0 + i * NGW; if (m < m_hi) { uint2 w; w.x = pk2(v[i][0], v[i][1]); w.y = pk2(v[i][2], v[i][3]); ((uint2*)(OSB(p, OS_PB) + ((size_t)l * MA + m) * DPLE))[lane] = w; } }
    }
}
__device__ __forceinline__ void prologue(KP p, LAS unsigned char* lds, int bid, int G, const int wid0) {
    int tid_ = TIDX(wid0); asm volatile("" : "+v"(tid_));
    const int tid = tid_, wave = __builtin_amdgcn_readfirstlane(tid >> 6), lane = tid & 63;
    const int gw = bid * NWAVES + wave, NGW = G * NWAVES;
    convert_layer(p, lds, 0, G == 256 ? 1 : 3, gw, NGW, wave, lane);
    if (G != 256) convert_layer(p, lds, 1, 3, gw, NGW, wave, lane);
    for (int m0 = gw; m0 < MA; m0 += 4 * NGW) {
        f32x4 v[4][4];
#pragma unroll
        for (int i = 0; i < 4; ++i) { const int m = m0 + i * NGW; const int mc = m < MA ? m : MA - 1;
            const float* xr = mc < MP ? p->in[I_XP] + (size_t)mc * DM : p->in[I_XS] + (size_t)(mc - MP) * DM;
#pragma unroll
            for (int j = 0; j < 4; ++j) v[i][j] = ((const f32x4*)xr)[lane + 64 * j]; }
#pragma unroll
        for (int i = 0; i < 4; ++i) { const int m = m0 + i * NGW; if (m < MA) { float s = 0.f; uint2* o8 = (uint2*)(WSB(p, WS_H0) + (size_t)m * DM);
#pragma unroll
            for (int j = 0; j < 4; ++j) { s += pg8::sq4(v[i][j]); uint2 w; w.x = pk2(v[i][j][0], v[i][j][1]); w.y = pk2(v[i][j][2], v[i][j][3]); o8[lane + 64 * j] = w; }
            s = wave_sum(s); if (lane == 0) WSF(p, WS_SSQ)[m] = s; } }
    }
    for (int i = bid * NT + tid; i < DEPTH * 4 * 64 * 64; i += G * NT) { const int c = i & 63, d = (i >> 6) & 63, lg_ = i >> 12; WSB(p, WS_PWT)[i] = (bf16_t)f2bf(p->in[I_POOLW][((size_t)lg_ * 64 + c) * 64 + d]); }
    for (int i = bid * NT + tid; i < 64 * 64; i += G * NT) ((unsigned*)(p->ws + WS_CNT))[i] = 0u;
    for (int i = bid * NT + tid; i < 6 * SSQ_STRIDE; i += G * NT) WSF(p, WS_SSQ)[SSQ_STRIDE + i] = 0.f;
}

constexpr int MXL_W = 0, MXL_G = 31 * DA * 4, MXL_P = MXL_G + 94 * DA * 2, MXL_END = MXL_P + 64 * 264 * 2;
constexpr int PLD = 264;
static_assert(MXL_END <= 160 * 1024 - 1024, "mixer LDS map");
__device__ __forceinline__ u32x4 ldg16(const void* p) { return *(const u32x4*)p; }
__device__ __forceinline__ void unpack8(const u32x4 w, float (&f)[8]) { f[0] = bf_lo(w.x); f[1] = bf_hi(w.x); f[2] = bf_lo(w.y); f[3] = bf_hi(w.y); f[4] = bf_lo(w.z); f[5] = bf_hi(w.z); f[6] = bf_lo(w.w); f[7] = bf_hi(w.w); }
__device__ __forceinline__ void mixer_prompt(KP p, bf16_t* MIX, LAS unsigned char* lds, int l, int chunk, const int wid0) {
    int tid_ = TIDX(wid0); asm volatile("" : "+v"(tid_));
    const int tid = tid_, wid = __builtin_amdgcn_readfirstlane(tid >> 6), lane = tid & 63;
    const int b = chunk >> 5, t0 = (chunk & 31) * 64; const size_t rowbase = (size_t)b * SEQ;
    const bf16_t* Zb = WSB(p, WS_Z) + rowbase * ZLD;
    LAS float* WL = (LAS float*)(lds + MXL_W); LAS bf16_t* GL = (LAS bf16_t*)(lds + MXL_G); LAS bf16_t* PL = (LAS bf16_t*)(lds + MXL_P);
    const u32x4 zero4 = (u32x4){0u, 0u, 0u, 0u};
    { const float* cw = p->in[I_CAW] + (size_t)l * 31 * DA;
      u32x4 wv[6], gv[9], xv[19];
#pragma unroll
      for (int i = 0; i < 6; ++i) { const int q = tid + NT * i; wv[i] = q < 31 * 96 ? ldg16(cw + q * 4) : zero4; }
#pragma unroll
      for (int i = 0; i < 9; ++i) { const int q = tid + NT * i, rr = q / 48, cc = q % 48, t = t0 - 30 + rr; const int tc = t > 0 ? t : 0;
          gv[i] = q < 94 * 48 ? ldg16(Zb + (size_t)tc * ZLD + cc * 8) : zero4; if (t < 0) gv[i] = zero4; }
      const int cc = tid & 31, rg = tid >> 5, c0 = cc * 8, w = 2 << (cc >> 3), ts = t0 + rg * 4;
#pragma unroll
      for (int i = 0; i < 19; ++i) { const int t = ts - 15 + i; xv[i] = ldg16(Zb + (size_t)(t > 0 ? t : 0) * ZLD + 384 + c0); if (t < 0 || i < 16 - w) xv[i] = zero4; }
#pragma unroll
      for (int i = 0; i < 6; ++i) { const int q = tid + NT * i; if (q < 31 * 96) *(LAS u32x4*)(WL + q * 4) = wv[i]; }
#pragma unroll
      for (int i = 0; i < 9; ++i) { const int q = tid + NT * i; if (q < 94 * 48) *(LAS u32x4*)(GL + q * 8) = gv[i]; }
      float S[8];
#pragma unroll
      for (int e = 0; e < 8; ++e) S[e] = 0.f;
#pragma unroll
      for (int i = 0; i < 15; ++i) { float f[8]; unpack8(xv[i], f);
#pragma unroll
          for (int e = 0; e < 8; ++e) S[e] += f[e]; }
#pragma unroll
      for (int r = 0; r < 4; ++r) { float cur[8]; unpack8(xv[15 + r], cur); const int t = ts + r; const float icnt = 1.0f / (float)(t + 1 < w ? t + 1 : w); float o[8];
#pragma unroll
          for (int e = 0; e < 8; ++e) { S[e] += cur[e]; o[e] = S[e] * icnt - cur[e]; }
          u32x4 ov; ov.x = pk2(o[0], o[1]); ov.y = pk2(o[2], o[3]); ov.z = pk2(o[4], o[5]); ov.w = pk2(o[6], o[7]);
          *(LAS u32x4*)(PL + (rg * 4 + r) * PLD + c0) = ov;
          u32x4 dv = zero4;
#pragma unroll
          for (int i = 0; i < 19; ++i) if (i == 16 + r - w) dv = xv[i];
          float d[8]; unpack8(dv, d);
#pragma unroll
          for (int e = 0; e < 8; ++e) S[e] -= d[e]; } }
    const float* lg = p->in[I_LNG] + l * DA; const float* lb = p->in[I_LNB] + l * DA; const float* cbias = p->in[I_CAB] + l * DA;
    float lgr[6], lbr[6], cbr[6];
#pragma unroll
    for (int i = 0; i < 6; ++i) { const int c = (i >> 1) * 128 + 2 * lane + (i & 1); lgr[i] = lg[c]; lbr[i] = lb[c]; cbr[i] = cbias[c]; }
    __syncthreads();
    const int c_cc = tid % 48, c_rg = tid / 48, c_c0 = c_cc * 8, c_ts = t0 + (c_rg & 7) * 8;
    u32x4 vv[10], cv[8];
#pragma unroll
    for (int i = 0; i < 10; ++i) { const int t = c_ts - 2 + i; vv[i] = ldg16(Zb + (size_t)(t > 0 ? t : 0) * ZLD + 1024 + c_c0); if (t < 0) vv[i] = zero4; }
#pragma unroll
    for (int i = 0; i < 8; ++i) cv[i] = ldg16(Zb + (size_t)(c_ts + i) * ZLD + 640 + c_c0);
    { typedef float f32x2 __attribute__((ext_vector_type(2)));
      f32x2 a0[3][8];
#pragma unroll
      for (int cb = 0; cb < 3; ++cb) { const int c = cb * 128 + 2 * lane;
          f32x2 w0[31];
#pragma unroll
          for (int k = 0; k < 31; ++k) w0[k] = *(const LAS f32x2*)(WL + k * DA + c);
#pragma unroll
          for (int j = 0; j < 8; ++j) a0[cb][j] = (f32x2){cbr[2 * cb], cbr[2 * cb + 1]};
#pragma unroll
          for (int s = 0; s < 38; ++s) {
              const unsigned gp = *(const LAS unsigned*)(GL + (wid * 8 + s) * DA + c); const f32x2 g0 = (f32x2){bf_lo(gp), bf_hi(gp)};
#pragma unroll
              for (int j = 0; j < 8; ++j) { const int k = s - j; if (k >= 0 && k <= 30) a0[cb][j] = __builtin_elementwise_fma(w0[k], g0, a0[cb][j]); }
          }
      }
#pragma unroll
      for (int j = 0; j < 8; ++j) { float s = 0.f, ss = 0.f;
#pragma unroll
          for (int cb = 0; cb < 3; ++cb) { s += a0[cb][j].x + a0[cb][j].y; ss += a0[cb][j].x * a0[cb][j].x + a0[cb][j].y * a0[cb][j].y; }
          s = wave_sum(s); ss = wave_sum(ss);
          const float mean = s * (1.0f / DA), rstd = rsqrtf(ss * (1.0f / DA) - mean * mean + 1e-6f);
          bf16_t* mr = MIX + (rowbase + t0 + wid * 8 + j) * DM;
#pragma unroll
          for (int cb = 0; cb < 3; ++cb) { const float y0 = (a0[cb][j].x - mean) * rstd * lgr[2 * cb] + lbr[2 * cb], y1 = (a0[cb][j].y - mean) * rstd * lgr[2 * cb + 1] + lbr[2 * cb + 1];
              *(unsigned*)(mr + cb * 128 + 2 * lane) = pk2(y0 * sigm(y0), y1 * sigm(y1)); } } }
    { const int g = wid & 3, rh = wid >> 2, i = lane & 15, q = lane >> 4; const bf16_t* wt = WSB(p, WS_PWT) + ((size_t)(l * 4 + g) * 64) * 64;
      bf16x8 af[2][2];
#pragma unroll
      for (int rt = 0; rt < 2; ++rt)
#pragma unroll
          for (int ks = 0; ks < 2; ++ks) af[rt][ks] = *(const LAS bf16x8*)(PL + ((rh * 2 + rt) * 16 + i) * PLD + g * 64 + ks * 32 + q * 8);
      const float* psc = p->in[I_POOLS] + l * DB + g * 64;
#pragma unroll
      for (int nt = 0; nt < 4; ++nt) { bf16x8 bfr[2];
#pragma unroll
          for (int ks = 0; ks < 2; ++ks) bfr[ks] = *(const bf16x8*)(wt + (size_t)(nt * 16 + i) * 64 + ks * 32 + q * 8);
          const f32x4 sc = *(const f32x4*)(psc + nt * 16 + 4 * q);
#pragma unroll
          for (int rt = 0; rt < 2; ++rt) { f32x4 acc = (f32x4){0.f, 0.f, 0.f, 0.f};
              acc = __builtin_amdgcn_mfma_f32_16x16x32_bf16(bfr[0], af[rt][0], acc, 0, 0, 0); acc = __builtin_amdgcn_mfma_f32_16x16x32_bf16(bfr[1], af[rt][1], acc, 0, 0, 0);
              st4bf(MIX + (rowbase + t0 + (rh * 2 + rt) * 16 + i) * DM + DA + g * 64 + nt * 16 + 4 * q, acc * sc); } } }
    if (tid < 384) { const float* w3 = p->in[I_CCW] + (size_t)l * 3 * DC + c_c0;
        float wa[8], wb[8], wc_[8];
#pragma unroll
        for (int h = 0; h < 2; ++h) { const f32x4 x0 = *(const f32x4*)(w3 + 4 * h), x1 = *(const f32x4*)(w3 + DC + 4 * h), x2 = *(const f32x4*)(w3 + 2 * DC + 4 * h);
#pragma unroll
            for (int e = 0; e < 4; ++e) { wa[4 * h + e] = x0[e]; wb[4 * h + e] = x1[e]; wc_[4 * h + e] = x2[e]; } }
#pragma unroll
        for (int r = 0; r < 8; ++r) { float f0[8], f1[8], f2[8], fc[8], o[8]; unpack8(vv[r], f0); unpack8(vv[r + 1], f1); unpack8(vv[r + 2], f2); unpack8(cv[r], fc);
#pragma unroll
            for (int e = 0; e < 8; ++e) o[e] = fc[e] * (wa[e] * f0[e] + wb[e] * f1[e] + wc_[e] * f2[e]);
            u32x4 ov; ov.x = pk2(o[0], o[1]); ov.y = pk2(o[2], o[3]); ov.z = pk2(o[4], o[5]); ov.w = pk2(o[6], o[7]);
            *(u32x4*)(MIX + (rowbase + c_ts + r) * DM + DA + DB + c_c0) = ov; } }
    if (t0 == SEQ - 64) {
        float* na = p->out + O_NAP + ((size_t)l * NB + b) * 30 * DA; float* np = p->out + O_NPP + ((size_t)l * NB + b) * 15 * DB; float* nc = p->out + O_NCP + ((size_t)l * NB + b) * 2 * DC;
        u32x4 sv[4]; float* dst[4];
#pragma unroll
        for (int i = 0; i < 4; ++i) { int q = tid + NT * i; const bf16_t* src = Zb; dst[i] = nullptr;
            if (q < 1440) { const int r = q / 48, c8 = (q % 48) * 8; src = Zb + (size_t)(SEQ - 30 + r) * ZLD + c8; dst[i] = na + r * DA + c8; }
            else if (q < 1920) { q -= 1440; const int r = q / 32, c8 = (q % 32) * 8; src = Zb + (size_t)(SEQ - 15 + r) * ZLD + 384 + c8; dst[i] = np + r * DB + c8; }
            else if (q < 2016) { q -= 1920; const int r = q / 48, c8 = (q % 48) * 8; src = Zb + (size_t)(SEQ - 2 + r) * ZLD + 1024 + c8; dst[i] = nc + r * DC + c8; }
            sv[i] = ldg16(src); }
#pragma unroll
        for (int i = 0; i < 4; ++i) if (dst[i]) { float f[8]; unpack8(sv[i], f); *(f32x4*)dst[i] = (f32x4){f[0], f[1], f[2], f[3]}; *(f32x4*)(dst[i] + 4) = (f32x4){f[4], f[5], f[6], f[7]}; }
    }
    __syncthreads();
}
__device__ __forceinline__ void st_bf16_pair_wt(bf16_t* row, int c, float v, int lane) {
    const unsigned me = f2bf(v), other = (unsigned)__shfl_xor((int)me, 1);
    if (!(lane & 1)) __hip_atomic_store((unsigned*)(row + c), me | (other << 16), __ATOMIC_RELAXED, __HIP_MEMORY_SCOPE_AGENT);
}
template <bool DO_A, bool DO_BC>
__device__ __forceinline__ void mixer_sample(KP p, bf16_t* MIX, LAS unsigned char* lds, int l, int j, const int wid0) {
    int tid_ = TIDX(wid0); asm volatile("" : "+v"(tid_));
    const int tid = tid_, wid = __builtin_amdgcn_readfirstlane(tid >> 6), lane = tid & 63;
    const float* z = WSF(p, WS_ZS) + (size_t)j * DINP; bf16_t* mr = MIX + (size_t)(MP + j) * DM;
    LAS float* red = (LAS float*)lds;
    LAS float* pooledL = (LAS float*)(lds + 256);
    float ya = 0.f;
    if (DO_A && tid < DA) {
        const int c = tid, zc = (c >> 7) * 256 + (c & 127); const float* cw = p->in[I_CAW] + (size_t)l * 31 * DA + c; const float* st = p->in[I_STA] + ((size_t)l * MS + j) * 30 * DA + c; float* na = p->out + O_NAS + ((size_t)l * MS + j) * 30 * DA + c;
        float sv[30], wv[31];
#pragma unroll
        for (int k = 0; k < 30; ++k) sv[k] = st[k * DA];
#pragma unroll
        for (int k = 0; k < 31; ++k) wv[k] = cw[k * DA];
        const float glu = z[zc] * sigm(z[zc + 128]); float a = p->in[I_CAB][l * DA + c] + wv[30] * glu;
#pragma unroll
        for (int k = 0; k < 30; ++k) a += wv[k] * sv[k];
#pragma unroll
        for (int k = 1; k < 30; ++k) na[(k - 1) * DA] = sv[k];
        na[29 * DA] = glu; ya = a;
    }
    if (DO_A) { const float s1 = wave_sum(ya), s2 = wave_sum(ya * ya); if (lane == 0) { red[wid] = s1; red[8 + wid] = s2; } }
    if (!DO_BC) {} else if (tid >= 256) {
        for (int c = tid - 256; c < DC; c += 256) { const int zc = (3 + (c >> 7)) * 256 + (c & 127); const float* st = p->in[I_STC] + ((size_t)l * MS + j) * 2 * DC; float* nc = p->out + O_NCS + ((size_t)l * MS + j) * 2 * DC; const float* w3 = p->in[I_CCW] + (size_t)l * 3 * DC;
            const float v = z[zc] * z[zc + 128], s0 = st[c], s1 = st[DC + c]; const float o = z[1792 + c] * (w3[c] * s0 + w3[DC + c] * s1 + w3[2 * DC + c] * v);
            nc[c] = s1; nc[DC + c] = v; st_bf16_pair_wt(mr, DA + DB + c, o, lane); }
    } else {
        const int c = tid, w = 2 << (c >> 6); const float* st = p->in[I_STP] + ((size_t)l * MS + j) * 15 * DB + c; float* np = p->out + O_NPS + ((size_t)l * MS + j) * 15 * DB + c;
        float sv[15];
#pragma unroll
        for (int k = 0; k < 15; ++k) sv[k] = st[k * DB];
        const float cur = z[1536 + c]; float S = cur;
#pragma unroll
        for (int k = 0; k < 15; ++k) if (k >= 16 - w) S += sv[k];
#pragma unroll
        for (int k = 1; k < 15; ++k) np[(k - 1) * DB] = sv[k];
        np[14 * DB] = cur; pooledL[c] = S / (float)w - cur;
    }
    __syncthreads();
    if (DO_A && tid < DA) {
        float s1 = 0.f, s2 = 0.f;
#pragma unroll
        for (int w = 0; w < 6; ++w) { s1 += red[w]; s2 += red[8 + w]; }
        const float mean = s1 * (1.0f / DA), var = s2 * (1.0f / DA) - mean * mean, rstd = rsqrtf(var + 1e-6f);
        const float y = (ya - mean) * rstd * p->in[I_LNG][l * DA + tid] + p->in[I_LNB][l * DA + tid]; st_bf16_pair_wt(mr, tid, y * sigm(y), lane);
    }
    if (DO_BC && tid < DB) {
        const int g = tid >> 6, d = tid & 63; const float* pw = p->in[I_POOLW] + ((size_t)l * 4 + g) * 64 * 64 + d; float o = 0.f;
        float wv[64];
#pragma unroll
        for (int cc = 0; cc < 64; ++cc) wv[cc] = pw[cc * 64];
#pragma unroll
        for (int c4 = 0; c4 < 16; ++c4) { const f32x4 pv = *(const LAS f32x4*)(pooledL + g * 64 + 4 * c4); o += pv[0] * wv[4 * c4] + pv[1] * wv[4 * c4 + 1] + pv[2] * wv[4 * c4 + 2] + pv[3] * wv[4 * c4 + 3]; }
        st_bf16_pair_wt(mr, DA + tid, o * p->in[I_POOLS][l * DB + tid], lane);
    }
    __syncthreads();
}

#define RLX_AGENT __ATOMIC_RELAXED, __HIP_MEMORY_SCOPE_AGENT
#define XB_TMO      128
#define XB_XCNT(j)  (256  + 64 * (j))
#define XB_XSUB(j)  (1280 + 64 * (j))
#define XB_XGEN(j)  (2304 + 64 * (j))
#define XB_TOP      3328
#define XB_TOPGEN   3392
#define XCD_BAR_WORDS 3456
#define XB_SPIN_CAP (1u << 18)

__device__ __forceinline__ unsigned xb_ld(unsigned* p)              { return __hip_atomic_load(p, __ATOMIC_RELAXED, __HIP_MEMORY_SCOPE_AGENT); }
__device__ __forceinline__ unsigned xb_add(unsigned* p, unsigned v) { return __hip_atomic_fetch_add(p, v, __ATOMIC_RELAXED, __HIP_MEMORY_SCOPE_AGENT); }
__device__ __forceinline__ unsigned xb_xcc_id() { return (unsigned)__builtin_amdgcn_s_getreg((3 << 11) | 20) & 0xFu; }
#define XB_SPIN(cond, bar) do { unsigned _sp = 0; while (cond) { __builtin_amdgcn_s_sleep(1); \
    if ((++_sp & 255u) == 0u) { if (xb_ld(&(bar)[XB_TMO])) break; if (_sp > XB_SPIN_CAP) { atomicAdd(&(bar)[XB_TMO], 1u); break; } } } } while (0)

struct XcdBarrier {
    unsigned* bar; unsigned x;
    volatile LAS unsigned* st;
};

__device__ __forceinline__ XcdBarrier xcd_barrier_post(unsigned* bar, volatile LAS unsigned* st, const int wid0) {
    XcdBarrier b; b.bar = bar; b.x = xb_xcc_id(); b.st = st;
    if (TIDX(wid0) == 0) (void)xb_add(&bar[XB_XCNT(b.x)], 1u);
    return b;
}
__device__ __forceinline__ void xcd_barrier_complete(unsigned* bar, unsigned x, unsigned& nloc, unsigned& nx) {
    const unsigned G = gridDim.x * gridDim.y * gridDim.z;
    unsigned sum, cnt, mine, sp = 0u;
    for (;;) {
        sum = 0u; cnt = 0u; mine = 0u;
#pragma unroll
        for (unsigned j = 0; j < 16; ++j) { const unsigned c = xb_ld(&bar[XB_XCNT(j)]); sum += c; cnt += (c > 0u) ? 1u : 0u; mine = (j == x) ? c : mine; }
        if (sum == G) break;
        __builtin_amdgcn_s_sleep(1);
        if ((++sp & 255u) == 0u) { if (xb_ld(&bar[XB_TMO])) break; if (sp > XB_SPIN_CAP) { atomicAdd(&bar[XB_TMO], 1u); break; } }
    }
    nloc = mine > 0u ? mine : 1u; nx = cnt > 0u ? cnt : 1u;
}

__device__ __forceinline__ void xcd_barrier(const XcdBarrier& b, const int wid0) {
    asm volatile("s_waitcnt vmcnt(0)" ::: "memory");
    __syncthreads();
    if (TIDX(wid0) == 0) {
        unsigned* bar = b.bar;
        __builtin_amdgcn_s_waitcnt(0);
        unsigned nloc = b.st[0], nx = b.st[1];
        if (nloc == 0u) { xcd_barrier_complete(bar, b.x, nloc, nx); b.st[0] = nloc; b.st[1] = nx; }
        const unsigned old = xb_add(&bar[XB_XSUB(b.x)], 1u);
        const unsigned gen = old / nloc;
        if (old + 1u == (gen + 1u) * nloc) {
            __builtin_amdgcn_fence(__ATOMIC_RELEASE, "agent");
            asm volatile("s_waitcnt vmcnt(0)" ::: "memory");
            const unsigned og = xb_add(&bar[XB_TOP], 1u);
            const unsigned tg = og / nx;
            if (og + 1u == (tg + 1u) * nx) xb_add(&bar[XB_TOPGEN], 1u);
            else XB_SPIN(xb_ld(&bar[XB_TOPGEN]) == tg, bar);
            __builtin_amdgcn_fence(__ATOMIC_ACQUIRE, "agent");
            xb_add(&bar[XB_XGEN(b.x)], 1u);
            asm volatile("s_waitcnt vmcnt(0)" ::: "memory");
        } else {
            XB_SPIN(xb_ld(&bar[XB_XGEN(b.x)]) == gen, bar);
            __builtin_amdgcn_fence(__ATOMIC_ACQUIRE, "agent");
            asm volatile("s_waitcnt vmcnt(0)" ::: "memory");
        }
    }
    __syncthreads();
}

__device__ __forceinline__ void group_barrier(unsigned* gw, unsigned target, unsigned* sw, unsigned starget, const int wid0, unsigned* ex0 = nullptr, unsigned* ex1 = nullptr, unsigned extarget = 0u) {
    asm volatile("s_waitcnt vmcnt(0)" ::: "memory");
    __syncthreads();
    if (TIDX(wid0) == 0) {
        (void)xb_add(gw, 1u);
        unsigned sp = 0; while (xb_ld(gw) < target) { if (++sp > (1u << 24)) break; }
        if (sw) { sp = 0; while (xb_ld(sw) < starget) { if (++sp > (1u << 24)) break; } }
        if (ex0) { sp = 0; while (xb_ld(ex0) < extarget || xb_ld(ex1) < extarget) { if (++sp > (1u << 24)) break; } }
        __builtin_amdgcn_fence(__ATOMIC_ACQUIRE, "agent");
        asm volatile("s_waitcnt vmcnt(0)" ::: "memory");
    }
    __syncthreads();
}
__device__ __forceinline__ void sample_arrive(unsigned* sw, const int wid0) {
    asm volatile("s_waitcnt vmcnt(0)" ::: "memory");
    __syncthreads();
    if (TIDX(wid0) == 0) (void)xb_add(sw, 1u);
}
__device__ __forceinline__ void sample_wait(unsigned* sw, unsigned target, const int wid0) {
    if (TIDX(wid0) == 0) {
        unsigned sp = 0; while (xb_ld(sw) < target) { __builtin_amdgcn_s_sleep(1); if (++sp > (1u << 24)) break; }
        __builtin_amdgcn_fence(__ATOMIC_ACQUIRE, "agent");
        asm volatile("s_waitcnt vmcnt(0)" ::: "memory");
    }
    __syncthreads();
}

struct ProjOrder {
    pg8::StaticOrder S; int grp, pm, member;
    __device__ __forceinline__ bool next(int i, pg8::Unit& u) const {
        if (!grp) return S.next(i, u);
        u.pm = pm; if (member == 1) { u.pn = i; return i < 2; } if (member >= 2) { u.pn = member; return i < 1; } return false;
    }
    __device__ __forceinline__ void a_ready(const pg8::Unit&) const {}
    __device__ __forceinline__ void done(const pg8::Unit&) const {}
};

__global__ void __launch_bounds__(NT, 2) fwd_megakernel(Params p_unused) {
    extern __shared__ __attribute__((aligned(16))) unsigned char lds_raw[];
    LAS unsigned char* lds = (LAS unsigned char*)lds_raw;
    cg::grid_group grid = cg::this_grid();
    const int bid = blockIdx.x, G = gridDim.x;
    const int wid0 = __builtin_amdgcn_readfirstlane((int)threadIdx.x >> 6);
    { volatile LAS unsigned* misc = (volatile LAS unsigned*)(lds + MISC_OFF); const int t0_ = TIDX(wid0); if (t0_ < 4) misc[t0_] = 0u; __syncthreads(); }
    if (G == 0x7fffffff) grid.sync();
    XcdBarrier bar;
    { KP p = get_kp(); bar = xcd_barrier_post((unsigned*)(p->ws + WS_BAR), (volatile LAS unsigned*)(lds + MISC_OFF), wid0); }
    if (TIDX(wid0) == 0) { KP p = get_kp(); __hip_atomic_store((unsigned*)(p->ws + WS_XID) + bid, 0x100u | xb_xcc_id(), __ATOMIC_RELAXED, __HIP_MEMORY_SCOPE_AGENT); }
#define GRID_BAR() xcd_barrier(bar, wid0)
#define HCUR(p, l) ((l) == 0 ? WSB(p, WS_H0) : OSB(p, OS_H1))
#define SSQ(p, i) (WSF(p, WS_SSQ) + (i) * SSQ_STRIDE)
#define MIXB(p, l) ((l) == 0 ? OSB(p, OS_H1) : WSB(p, WS_H0))
    { KP p = get_kp(); prologue(p, lds, bid, G, wid0); }
    GRID_BAR();
    if (TIDX(wid0) == 0 && G == 256) { KP p = get_kp(); unsigned* xid = (unsigned*)(p->ws + WS_XID); const unsigned mine = 0x100u | xb_xcc_id(); bool ok = true;
        for (int m = 0; m < 4; ++m) ok = ok && (xb_ld(xid + (bid & 63) + 64 * m) == mine);
        if (!ok) __hip_atomic_store((unsigned*)(p->ws + WS_SLOW), 1u, __ATOMIC_RELAXED, __HIP_MEMORY_SCOPE_AGENT); }
    unsigned gseam = 0, sslot = 0; bool fast_last = false;

#pragma unroll 1
    for (int l = 0; l < DEPTH; ++l) {
        const int off64 = (G > 64) ? 64 : 0;
        { KP p = get_kp(); pg8::Gemm g{HCUR(p, l), WSB(p, WS_WIN) + (size_t)l * DINP * DM, MP, 2048, DM}; pg8::StaticOrder S; S.init(MP, 2048, G, bid); pg8::EpiZ E{WSB(p, WS_Z), SSQ(p, 3 * l), 0};
          pg8::gemm_phase<pg8::EpiZ, pg8::StaticOrder, true, true>(lds, g, S, E, wid0); }
        { KP p = get_kp(); pg8::Gemm g{HCUR(p, l), WSB(p, WS_WIN) + ((size_t)l * DINP + 2048) * DM, MP, 256, DM}; pg8::StaticOrder S; S.init(MP, 256, G, bid); pg8::EpiZ E{WSB(p, WS_Z), SSQ(p, 3 * l), 8};
          pg8::gemm_phase<pg8::EpiZ, pg8::StaticOrder, true, true, true>(lds, g, S, E, wid0); }
        if (bid >= off64) {
            { KP p = get_kp(); int kple = DPLE; asm volatile("" : "+s"(kple));
              pg8::Gemm g{OSB(p, OS_PB) + (size_t)l * MA * DPLE, WSB(p, WS_WPP) + (size_t)l * DM * DPLE, MP, DM, kple};
              ProjOrder S; S.S.init(MP, DM, G - off64, bid - off64); S.grp = (G == 256); S.pm = 8 * (bid & 7) + ((bid >> 3) & 7); S.member = bid >> 6; pg8::EpiPlain E{WSB(p, WS_P), DM};
              pg8::gemm_phase<pg8::EpiPlain, ProjOrder, true, true>(lds, g, S, E, wid0); }
            { KP p = get_kp(); SkZ E{WSF(p, WS_ZS), SSQ(p, 3 * l)}; skinny_gemm<8>(lds, HCUR(p, l) + (size_t)MP * DM, WSB(p, WS_WIN) + (size_t)l * DINP * DM, DINP, DM, bid - off64, G - off64, E, wid0); }
            { KP p = get_kp(); SkPlain E{WSF(p, WS_PS), DM}; skinny_gemm<8>(lds, OSB(p, OS_PB) + ((size_t)l * MA + MP) * DPLE, WSB(p, WS_WPP) + (size_t)l * DM * DPLE, DM, DPLE, (bid - off64 + (G - off64) - 144 % (G - off64)) % (G - off64), G - off64, E, wid0); }
        }
        if (G == 256) { KP p = get_kp(); int tid = TIDX(wid0); asm volatile("" : "+v"(tid)); const int wave = __builtin_amdgcn_readfirstlane(tid >> 6), lane = tid & 63;
            int flo, fhi, gv, NV;
            if (bid < 64) { flo = 0; fhi = CV_A; gv = bid * NWAVES + wave; NV = 64 * NWAVES; }
            else if (bid < 128) { flo = CV_A; fhi = CV_B; gv = (bid - 64) * NWAVES + wave; NV = 64 * NWAVES; }
            else { flo = CV_B; fhi = 64; gv = (bid - 128) * NWAVES + wave; NV = 128 * NWAVES; }
            convert_layer(p, lds, l, 2, gv, NV, wave, lane, flo, fhi); if (l + 1 < DEPTH) convert_layer(p, lds, l + 1, 1, gv, NV, wave, lane, flo, fhi);
        }
        GRID_BAR();
        bool fast; { KP p = get_kp(); fast = (G == 256) && (__builtin_amdgcn_readfirstlane((int)xb_ld((unsigned*)(p->ws + WS_SLOW))) == 0); } fast_last = fast;
#define SEAM() do { if (fast) { KP p_ = get_kp(); ++gseam; group_barrier((unsigned*)(p_->ws + WS_GRP) + 64 * (bid & 63), 4u * gseam, (unsigned*)(p_->ws + WS_SCNT) + 64 * (sslot - 1), (unsigned)G, wid0); } else { GRID_BAR(); } } while (0)
#define S_ARRIVE() do { if (fast) { KP p_ = get_kp(); sample_arrive((unsigned*)(p_->ws + WS_SCNT) + 64 * sslot, wid0); ++sslot; } } while (0)
        for (int it = bid + 256; it < 256 + 2 * MS; it += G) { KP p = get_kp();
            if (it < 256 + MS) mixer_sample<true, false>(p, MIXB(p, l), lds, l, it - 256, wid0);
            else mixer_sample<false, true>(p, MIXB(p, l), lds, l, it - 256 - MS, wid0);
        }
        S_ARRIVE();
        for (int it = bid; it < 256; it += G) { KP p = get_kp();
            mixer_prompt(p, MIXB(p, l), lds, l, G == 256 ? 4 * (8 * (it & 7) + ((it >> 3) & 7)) + (it >> 6) : it, wid0); }
        SEAM();
        const unsigned gs_mix = gseam;
        { KP p = get_kp(); SkRes E{HCUR(p, l), HCUR(p, l), SSQ(p, 3 * l + 1)}; skinny_gemm<2>(lds, MIXB(p, l) + (size_t)MP * DM, WSB(p, WS_WOUT) + (size_t)l * DM * DM, DM, DM, bid, G, E, wid0); }
        S_ARRIVE();
        { KP p = get_kp(); pg8::Gemm g{MIXB(p, l), WSB(p, WS_WOUT) + (size_t)l * DM * DM, MP, DM, DM}; pg8::StaticOrder S; S.init(MP, DM, G, bid); pg8::EpiRes E{HCUR(p, l), HCUR(p, l), SSQ(p, 3 * l + 1)};
          pg8::gemm_phase<pg8::EpiRes, pg8::StaticOrder, true, true>(lds, g, S, E, wid0); }
        if (fast) { KP p_ = get_kp(); ++gseam; unsigned* gb = (unsigned*)(p_->ws + WS_GRP); const int pmA = 8 * (bid & 7) + ((bid >> 3) & 7), qn = pmA + 1; unsigned* nb = (pmA & 7) != 7 ? gb + 64 * ((qn >> 3) + 8 * (qn & 7)) : nullptr;
            group_barrier(gb + 64 * (bid & 63), 4u * gseam, (unsigned*)(p_->ws + WS_SCNT) + 64 * (sslot - 1), (unsigned)G, wid0, nb, nb, 4u * gs_mix); }
        else GRID_BAR();
        { KP p = get_kp(); SkUp E{WSB(p, WS_U), SSQ(p, 3 * l + 1)}; skinny_gemm<8>(lds, HCUR(p, l) + (size_t)MP * DM, WSB(p, WS_WUP) + (size_t)l * DFF * DM, DFF, DM, bid, G, E, wid0); }
        S_ARRIVE();
        { KP p = get_kp(); pg8::Gemm g{HCUR(p, l), WSB(p, WS_WUP) + (size_t)l * DFF * DM, MP, DFF, DM}; pg8::StaticOrder S; S.init(MP, DFF, G, bid); pg8::EpiUp E{WSB(p, WS_U), SSQ(p, 3 * l + 1)};
          pg8::gemm_phase<pg8::EpiUp, pg8::StaticOrder, true, true>(lds, g, S, E, wid0); }
        SEAM();
        { KP p = get_kp(); bf16_t* h5 = (l == DEPTH - 1) ? WSB(p, WS_H0) : HCUR(p, l);
          SkRes E{HCUR(p, l), h5, SSQ(p, 3 * l + 2)}; skinny_gemm<2>(lds, WSB(p, WS_U) + (size_t)MP * DFF, WSB(p, WS_WDOWN) + (size_t)l * DM * DFF, DM, DFF, bid, G, E, wid0); }
        S_ARRIVE();
        { KP p = get_kp(); bf16_t* h5 = (l == DEPTH - 1) ? WSB(p, WS_H0) : HCUR(p, l);
          pg8::Gemm g{WSB(p, WS_U), WSB(p, WS_WDOWN) + (size_t)l * DM * DFF, MP, DM, DFF}; pg8::StaticOrder S; S.init(MP, DM, G, bid); pg8::EpiRes E{HCUR(p, l), h5, SSQ(p, 3 * l + 2)};
          pg8::gemm_phase<pg8::EpiRes, pg8::StaticOrder, true, true>(lds, g, S, E, wid0); }
        if (l == DEPTH - 1 && fast) { KP p_ = get_kp(); ++gseam; unsigned* gb = (unsigned*)(p_->ws + WS_GRP); const int pmA = 8 * (bid & 7) + ((bid >> 3) & 7), q0 = 2 * pmA, q1 = 2 * pmA + 1;
            group_barrier(gb + 64 * (bid & 63), 4u * gseam, (unsigned*)(p_->ws + WS_SCNT) + 64 * (sslot - 1), (unsigned)G, wid0,
                          pmA < 32 ? gb + 64 * ((q0 >> 3) + 8 * (q0 & 7)) : nullptr, pmA < 32 ? gb + 64 * ((q1 >> 3) + 8 * (q1 & 7)) : nullptr, 4u * gseam); }
        else SEAM();
        if (l == DEPTH - 1) {
            { KP p = get_kp(); SkGate<true> E{WSB(p, WS_H0), WSF(p, WS_PS), nullptr, p->out, SSQ(p, 3 * l + 2), SSQ(p, 3 * l + 3)}; skinny_gemm<2>(lds, WSB(p, WS_H0) + (size_t)MP * DM, WSB(p, WS_WPG) + (size_t)l * DM * DM, DM, DM, bid, G, E, wid0); }
            S_ARRIVE();
            if (G == 256) { KP p = get_kp(); pg8::Gemm g{WSB(p, WS_H0), WSB(p, WS_WPG) + (size_t)l * DM * DM, MP, DM, DM}; pg8::StaticOrder S; S.init(MP, DM, G, bid);
              pg8::EpiGateFinal E{WSB(p, WS_H0), WSB(p, WS_P), p->out, SSQ(p, 3 * l + 2), SSQ(p, 3 * l + 3), (unsigned*)(p->ws + WS_CNT), p->in[I_GFIN]};
              pg8::gemm_phase<pg8::EpiGateFinal, pg8::StaticOrder, true, true>(lds, g, S, E, wid0); }
            else { KP p = get_kp(); pg8::Gemm g{WSB(p, WS_H0), WSB(p, WS_WPG) + (size_t)l * DM * DM, MP, DM, DM}; pg8::StaticOrder S; S.init(MP, DM, G, bid);
              pg8::EpiGate<true> E{WSB(p, WS_H0), WSB(p, WS_P), nullptr, p->out, SSQ(p, 3 * l + 2), SSQ(p, 3 * l + 3)};
              pg8::gemm_phase<pg8::EpiGate<true>, pg8::StaticOrder, true, true>(lds, g, S, E, wid0); }
        } else {
            { KP p = get_kp(); SkGate<false> E{WSB(p, WS_H0), WSF(p, WS_PS), OSB(p, OS_H1), nullptr, SSQ(p, 3 * l + 2), SSQ(p, 3 * l + 3)}; skinny_gemm<2>(lds, WSB(p, WS_H0) + (size_t)MP * DM, WSB(p, WS_WPG) + (size_t)l * DM * DM, DM, DM, bid, G, E, wid0); }
            S_ARRIVE();
            { KP p = get_kp(); pg8::Gemm g{WSB(p, WS_H0), WSB(p, WS_WPG) + (size_t)l * DM * DM, MP, DM, DM}; pg8::StaticOrder S; S.init(MP, DM, G, bid); pg8::EpiGate<false> E{WSB(p, WS_H0), WSB(p, WS_P), OSB(p, OS_H1), nullptr, SSQ(p, 3 * l + 2), SSQ(p, 3 * l + 3)};
              pg8::gemm_phase<pg8::EpiGate<false>, pg8::StaticOrder, true, true>(lds, g, S, E, wid0); }
        }
        if (fast) { if (l < DEPTH - 1) SEAM(); } else GRID_BAR();
    }
    if (fast_last) { KP p_ = get_kp(); sample_wait((unsigned*)(p_->ws + WS_SCNT) + 64 * (sslot - 1), (unsigned)G, wid0); }
    { KP p = get_kp(); int tid = TIDX(wid0); asm volatile("" : "+v"(tid)); const int wave = __builtin_amdgcn_readfirstlane(tid >> 6), lane = tid & 63; const float* ssqf = SSQ(p, 6); const f32x4* gf = (const f32x4*)p->in[I_GFIN];
      for (int m = (G == 256 ? MP : 0) + bid * NWAVES + wave; m < MA; m += G * NWAVES) {     const float rs = rs_of(ssqf[m]); f32x4* yr = (f32x4*)(p->out + (size_t)m * DM);
#pragma unroll
          for (int j = 0; j < 4; ++j) { const f32x4 v = yr[lane + 64 * j]; yr[lane + 64 * j] = v * rs * gf[lane + 64 * j]; } } }
}

extern "C" void kernel_launch(void* const* d_in, const int* in_sizes, int n_in, void* d_out, int out_size, void* d_ws, size_t ws_size, hipStream_t stream) {
    static int grid_blocks = 0;
    if (grid_blocks == 0) {
        if (n_in != 24 || (size_t)out_size != O_END || ws_size < WS_END) { fprintf(stderr, "kernel_launch: unexpected shapes: n_in %d out %d ws %zu\n", n_in, out_size, ws_size); grid_blocks = -1; return; }
        int dev = 0, cus = 0, per_cu = 0;
        (void)hipGetDevice(&dev); (void)hipDeviceGetAttribute(&cus, hipDeviceAttributeMultiprocessorCount, dev);
        (void)hipFuncSetAttribute((const void*)fwd_megakernel, hipFuncAttributeMaxDynamicSharedMemorySize, LDS_BYTES);
        (void)hipOccupancyMaxActiveBlocksPerMultiprocessor(&per_cu, (const void*)fwd_megakernel, NT, LDS_BYTES);
        if (per_cu < 1) { fprintf(stderr, "kernel_launch: occupancy query says %d blocks per CU\n", per_cu); per_cu = 1; }
        grid_blocks = cus * (per_cu > 1 ? 1 : per_cu);
    }
    if (grid_blocks < 0) return;
    Params p{};
    for (int i = 0; i < 24; ++i) p.in[i] = (const float*)d_in[i];
    p.out = (float*)d_out; p.ws = (unsigned char*)d_ws;
    (void)hipMemsetAsync((unsigned char*)d_ws + WS_BAR, 0, WS_CTL_END - WS_BAR, stream);
    void* args[] = {&p};
    hipError_t e = hipLaunchCooperativeKernel((const void*)fwd_megakernel, dim3(grid_blocks), dim3(NT), args, LDS_BYTES, stream);
    if (e != hipSuccess) fprintf(stderr, "cooperative launch failed: %s (grid %d)\n", hipGetErrorString(e), grid_blocks);
}
```
